# Optimizing an MI355X kernel written in HIP

```python
import jax, jax.numpy as jnp
from jax import lax
import numpy as np

D_MODEL = 1024
BATCH = 16
SEQ = 256
DEPTH = 1
DEC_BATCH = 2
DEC_SEQ = 2048
PAST_LEN = 256

GRID_W = 64
MLA_HEADS = 8
Q_RANK = 384
KV_RANK = 256
NOPE_DIM = 64
ROPE_DIM = 32
MLA_V_DIM = 64
ROPE_BASE = 10000.0
Q_BLOCK = 128
MLA_SCALE = (NOPE_DIM + ROPE_DIM) ** -0.5
MLSTM_HEADS = 4
MLSTM_DK = 128
MLSTM_DV = 256
MLSTM_CHUNK = 64
FFN_HIDDEN = ((8 * D_MODEL // 3 + 255) // 256) * 256
EPS = 1e-6
IN_SIZES = (Q_RANK, KV_RANK, ROPE_DIM,
            MLSTM_HEADS * MLSTM_DK, MLSTM_HEADS * MLSTM_DK, MLSTM_HEADS * MLSTM_DV,
            4 * MLSTM_HEADS, MLSTM_HEADS * MLSTM_DV, 2 * D_MODEL)
N_IN = Q_RANK + KV_RANK + ROPE_DIM + 2 * MLSTM_HEADS * MLSTM_DK + 2 * MLSTM_HEADS * MLSTM_DV + 4 * MLSTM_HEADS + 2 * D_MODEL

kernel_name = "hybrid_mla_mlstm_diffusion_step"


def rmsnorm(x, g):
    xf = x.astype(jnp.float32)
    y = xf * lax.rsqrt(jnp.mean(xf * xf, axis=-1, keepdims=True) + EPS)
    return (y * g.astype(jnp.float32)).astype(x.dtype)


def adaln(cond, w_mod, b_mod):
    mod = jax.nn.silu(cond) @ w_mod + b_mod
    mod = mod.reshape(cond.shape[0], 1, 6, D_MODEL)
    return [mod[:, :, i] for i in range(6)]


def grid_angles(n_tokens):
    rows = n_tokens // GRID_W
    r, col = jnp.meshgrid(jnp.arange(rows, dtype=jnp.float32), jnp.arange(GRID_W, dtype=jnp.float32), indexing='ij')
    half = ROPE_DIM // 2
    inv = ROPE_BASE ** (-jnp.arange(0, half, 2, dtype=jnp.float32) / half)
    return r.reshape(-1, 1) * inv, col.reshape(-1, 1) * inv


def rope_2d(x, ang_r, ang_c):
    xf = x.astype(jnp.float32)

    def rot(xh, ang):
        x1, x2 = jnp.split(xh, 2, axis=-1)
        cs, sn = jnp.cos(ang), jnp.sin(ang)
        return jnp.concatenate([x1 * cs - x2 * sn, x1 * sn + x2 * cs], axis=-1)

    half = ROPE_DIM // 2
    out = jnp.concatenate([rot(xf[..., :half], ang_r), rot(xf[..., half:], ang_c)], axis=-1)
    return out.astype(x.dtype)


def mla_attend(q_nope, q_pe, k_nope, k_pe, v):
    B, Sq, H, _ = q_nope.shape
    nb = Sq // Q_BLOCK
    qn = jnp.moveaxis(q_nope.reshape(B, nb, Q_BLOCK, H, NOPE_DIM), 1, 0)
    qp = jnp.moveaxis(q_pe.reshape(B, nb, Q_BLOCK, H, ROPE_DIM), 1, 0)

    def block(args):
        qn_b, qp_b = args
        s = jnp.einsum('bqhd,bkhd->bhqk', qn_b, k_nope) + jnp.einsum('bqhr,bkr->bhqk', qp_b, k_pe)
        p = jax.nn.softmax(s.astype(jnp.float32) * MLA_SCALE, axis=-1)
        return jnp.einsum('bhqk,bkhv->bqhv', p.astype(v.dtype), v)

    out = lax.map(block, (qn, qp))
    return jnp.moveaxis(out, 0, 1).reshape(B, Sq, H * MLA_V_DIM)


def mlstm_scan(q, k, v, ig, lf, C0, n0, m0):
    B, S, H, _ = q.shape
    L = MLSTM_CHUNK
    nc = S // L
    f32 = jnp.float32

    def chunks(t):
        t = t.astype(f32).reshape((B, nc, L, H) + t.shape[3:])
        return jnp.moveaxis(jnp.moveaxis(t, 1, 0), 3, 2)

    mask = jnp.tril(jnp.ones((L, L), dtype=bool))

    def step(carry, xs):
        C, n, m = carry
        qc, kc, vc, ic, fc = xs
        b = jnp.cumsum(fc, axis=-1)
        log_d = jnp.where(mask, b[..., :, None] - b[..., None, :] + ic[..., None, :], -jnp.inf)
        inter = b + m[..., None]
        m_row = jnp.maximum(inter, jnp.max(log_d, axis=-1))
        d = jnp.exp(log_d - m_row[..., None])
        w_inter = jnp.exp(inter - m_row)
        s = jnp.einsum('bhjd,bhsd->bhjs', qc, kc) * d
        num = jnp.einsum('bhjs,bhsv->bhjv', s, vc) + w_inter[..., None] * jnp.einsum('bhvd,bhjd->bhjv', C, qc)
        den = jnp.sum(s, axis=-1) + w_inter * jnp.einsum('bhd,bhjd->bhj', n, qc)
        h = num / jnp.maximum(jnp.abs(den), jnp.exp(-m_row))[..., None]
        b_last = b[..., -1]
        log_w = b_last[..., None] - b + ic
        m_new = jnp.maximum(b_last + m, jnp.max(log_w, axis=-1))
        w = jnp.exp(log_w - m_new[..., None])
        decay = jnp.exp(b_last + m - m_new)
        C_new = decay[..., None, None] * C + jnp.einsum('bhs,bhsv,bhsd->bhvd', w, vc, kc)
        n_new = decay[..., None] * n + jnp.einsum('bhs,bhsd->bhd', w, kc)
        return (C_new, n_new, m_new), h

    (C, n, m), h = lax.scan(step, (C0.astype(f32), n0.astype(f32), m0.astype(f32)),
                            (chunks(q), chunks(k), chunks(v), chunks(ig), chunks(lf)))
    h = jnp.moveaxis(jnp.moveaxis(h, 0, 1), 2, 3).reshape(B, S, H, v.shape[-1])
    return h.astype(v.dtype), (C, n, m)


def bidirectional_mlstm(q, k, v, ig_f, lf_f, ig_b, lf_b, C0, n0, m0):
    h_f, (Cf, nf, mf) = mlstm_scan(q, k, v, ig_f, lf_f, C0[:, 0], n0[:, 0], m0[:, 0])
    flip = lambda t: jnp.flip(t, axis=1)
    h_b, (Cb, nb, mb) = mlstm_scan(flip(q), flip(k), flip(v), flip(ig_b), flip(lf_b), C0[:, 1], n0[:, 1], m0[:, 1])
    h = h_f + flip(h_b)
    return h, (jnp.stack([Cf, Cb], axis=1), jnp.stack([nf, nb], axis=1), jnp.stack([mf, mb], axis=1))


def mixer(h, p, ctx, angles, state0):
    B, S, _ = h.shape
    z = h @ p['w_in']
    offsets = np.cumsum(IN_SIZES)[:-1].tolist()
    zq, zkv, zkpe, zmq, zmk, zmv, zgate, zmo, zbr = jnp.split(z, offsets, axis=-1)
    q = (rmsnorm(zq, p['g_q_norm']) @ p['w_uq']).reshape(B, S, MLA_HEADS, NOPE_DIM + ROPE_DIM)
    q_nope, q_pe = q[..., :NOPE_DIM], q[..., NOPE_DIM:]
    ckv = rmsnorm(zkv, p['g_kv_norm'])
    kpe = zkpe
    if angles is None:
        ckv_all, kpe_all = ckv, kpe
    else:
        ang_r, ang_c = angles
        q_pe = rope_2d(q_pe, ang_r[:, None, :], ang_c[:, None, :])
        ckv_all = jnp.concatenate([ckv, ctx[0].astype(ckv.dtype)], axis=1)
        kpe_all = jnp.concatenate([rope_2d(kpe, ang_r, ang_c), ctx[1].astype(kpe.dtype)], axis=1)
    Sk = ckv_all.shape[1]
    kv = (ckv_all @ p['w_ukv']).reshape(B, Sk, MLA_HEADS, NOPE_DIM + MLA_V_DIM)
    att = mla_attend(q_nope, q_pe, kv[..., :NOPE_DIM], kpe_all, kv[..., NOPE_DIM:])
    mq = zmq.reshape(B, S, MLSTM_HEADS, MLSTM_DK)
    mk = zmk.reshape(B, S, MLSTM_HEADS, MLSTM_DK) * (MLSTM_DK ** -0.5)
    mv = zmv.reshape(B, S, MLSTM_HEADS, MLSTM_DV)
    gates = (zgate + p['b_gates']).astype(jnp.float32).reshape(B, S, 4, MLSTM_HEADS)
    ig_f, ig_b = gates[:, :, 0], gates[:, :, 1]
    lf_f, lf_b = jax.nn.log_sigmoid(gates[:, :, 2]), jax.nn.log_sigmoid(gates[:, :, 3])
    hm, new_state = bidirectional_mlstm(mq, mk, mv, ig_f, lf_f, ig_b, lf_b, *state0)
    hm = rmsnorm(hm, p['g_mlstm_norm'].reshape(MLSTM_HEADS, MLSTM_DV)).reshape(B, S, MLSTM_HEADS * MLSTM_DV)
    hm = hm * jax.nn.sigmoid(zmo)
    g_a, g_b = jnp.split(jax.nn.sigmoid(zbr), 2, axis=-1)
    out = (g_a * (att @ p['w_o_mla']) + g_b * (hm @ p['w_o_mlstm'])) @ p['w_out']
    return out, ckv, kpe, new_state


def block(x, cond, p, ctx, angles, state0):
    sh1, sc1, gt1, sh2, sc2, gt2 = adaln(cond, p['w_mod'], p['b_mod'])
    h = rmsnorm(x, p['g_norm_mix']) * (1.0 + sc1) + sh1
    out, ckv, kpe, st = mixer(h, p, ctx, angles, state0)
    x = x + gt1 * out
    h = rmsnorm(x, p['g_norm_ffn']) * (1.0 + sc2) + sh2
    a, u = jnp.split(h @ p['w_ffn_in'], 2, axis=-1)
    x = x + gt2 * ((jax.nn.silu(a) * u) @ p['w_ffn_out'])
    return x, ckv, kpe, st


def setup_inputs(seed: int = 0) -> dict:
    key = jax.random.key(seed)
    ks = jax.random.split(key, 32)
    f32 = jnp.float32
    D = D_MODEL

    def nrm(k, shape, scale=1.0):
        return scale * jax.random.normal(k, shape, f32)

    def gain(k, shape):
        return 1.0 + 0.1 * nrm(k, shape)

    i_bias = 0.1 * nrm(ks[13], (DEPTH, 2 * MLSTM_HEADS))
    f_bias = jnp.tile(jnp.linspace(3.0, 6.0, MLSTM_HEADS), 2)[None, :] + 0.1 * nrm(ks[14], (DEPTH, 2 * MLSTM_HEADS))
    return {
        'x_prompt': nrm(ks[0], (BATCH, SEQ, D)),
        'x_sample': nrm(ks[1], (DEC_BATCH, DEC_SEQ, D)),
        'cache_ckv': nrm(ks[2], (DEC_BATCH, DEPTH, PAST_LEN, KV_RANK)),
        'cache_krope': nrm(ks[3], (DEC_BATCH, DEPTH, PAST_LEN, ROPE_DIM)),
        'state_C': nrm(ks[4], (DEC_BATCH, DEPTH, 2, MLSTM_HEADS, MLSTM_DV, MLSTM_DK), 0.1),
        'state_n': nrm(ks[5], (DEC_BATCH, DEPTH, 2, MLSTM_HEADS, MLSTM_DK), 0.1),
        'state_m': nrm(ks[6], (DEC_BATCH, DEPTH, 2, MLSTM_HEADS), 0.5),
        'c': nrm(ks[7], (DEC_BATCH, D)),
        'c_ctx': nrm(ks[8], (D,)),
        'w_mod': nrm(ks[9], (DEPTH, D, 6 * D), 0.5 * D ** -0.5),
        'b_mod': nrm(ks[10], (DEPTH, 6 * D), 0.02),
        'g_norm_mix': gain(ks[11], (DEPTH, D)),
        'w_in': nrm(ks[12], (DEPTH, D, N_IN), D ** -0.5),
        'b_gates': jnp.concatenate([i_bias, f_bias], axis=-1),
        'g_q_norm': gain(ks[15], (DEPTH, Q_RANK)),
        'w_uq': nrm(ks[16], (DEPTH, Q_RANK, MLA_HEADS * (NOPE_DIM + ROPE_DIM)), Q_RANK ** -0.5),
        'g_kv_norm': gain(ks[17], (DEPTH, KV_RANK)),
        'w_ukv': nrm(ks[18], (DEPTH, KV_RANK, MLA_HEADS * (NOPE_DIM + MLA_V_DIM)), KV_RANK ** -0.5),
        'g_mlstm_norm': gain(ks[19], (DEPTH, MLSTM_HEADS * MLSTM_DV)),
        'w_o_mla': nrm(ks[20], (DEPTH, MLA_HEADS * MLA_V_DIM, D), (MLA_HEADS * MLA_V_DIM) ** -0.5),
        'w_o_mlstm': nrm(ks[21], (DEPTH, MLSTM_HEADS * MLSTM_DV, D), (MLSTM_HEADS * MLSTM_DV) ** -0.5),
        'w_out': nrm(ks[22], (DEPTH, D, D), D ** -0.5),
        'g_norm_ffn': gain(ks[23], (DEPTH, D)),
        'w_ffn_in': nrm(ks[24], (DEPTH, D, 2 * FFN_HIDDEN), D ** -0.5),
        'w_ffn_out': nrm(ks[25], (DEPTH, FFN_HIDDEN, D), FFN_HIDDEN ** -0.5),
        'g_final': gain(ks[26], (D,)),
    }


def reference(x_prompt, x_sample, cache_ckv, cache_krope, state_C, state_n, state_m, c, c_ctx,
              w_mod, b_mod, g_norm_mix, w_in, b_gates, g_q_norm, w_uq, g_kv_norm, w_ukv,
              g_mlstm_norm, w_o_mla, w_o_mlstm, w_out, g_norm_ffn, w_ffn_in, w_ffn_out, g_final):
    def layer_params(l):
        return {'w_mod': w_mod[l], 'b_mod': b_mod[l], 'g_norm_mix': g_norm_mix[l], 'w_in': w_in[l],
                'b_gates': b_gates[l], 'g_q_norm': g_q_norm[l], 'w_uq': w_uq[l], 'g_kv_norm': g_kv_norm[l],
                'w_ukv': w_ukv[l], 'g_mlstm_norm': g_mlstm_norm[l], 'w_o_mla': w_o_mla[l],
                'w_o_mlstm': w_o_mlstm[l], 'w_out': w_out[l], 'g_norm_ffn': g_norm_ffn[l],
                'w_ffn_in': w_ffn_in[l], 'w_ffn_out': w_ffn_out[l]}

    bp = x_prompt.shape[0]
    C0 = jnp.zeros((bp, 2, MLSTM_HEADS, MLSTM_DV, MLSTM_DK), jnp.float32)
    n0 = jnp.zeros((bp, 2, MLSTM_HEADS, MLSTM_DK), jnp.float32)
    m0 = jnp.zeros((bp, 2, MLSTM_HEADS), jnp.float32)
    xp = x_prompt
    ckv_l, kpe_l, C_l, n_l, m_l = [], [], [], [], []
    for l in range(DEPTH):
        xp, ckv, kpe, (Cc, nc_, mc) = block(xp, c_ctx[None, :], layer_params(l), None, None, (C0, n0, m0))
        ckv_l.append(ckv); kpe_l.append(kpe); C_l.append(Cc); n_l.append(nc_); m_l.append(mc)
    y_prompt = rmsnorm(xp, g_final)
    new_ckv = jnp.stack(ckv_l, axis=1)
    new_krope = jnp.stack(kpe_l, axis=1)
    new_C = jnp.stack(C_l, axis=1)
    new_n = jnp.stack(n_l, axis=1)
    new_m = jnp.stack(m_l, axis=1)

    angles = grid_angles(x_sample.shape[1])
    xs = x_sample
    for l in range(DEPTH):
        xs, _, _, _ = block(xs, c, layer_params(l), (cache_ckv[:, l], cache_krope[:, l]), angles,
                            (state_C[:, l], state_n[:, l], state_m[:, l]))
    y_sample = rmsnorm(xs, g_final)
    return (y_prompt, y_sample, new_ckv, new_krope, new_C, new_n, new_m)
```

```cpp
#include <hip/hip_runtime.h>
#include <hip/hip_cooperative_groups.h>
#include <cstdio>
#include <cstdint>
namespace cg = cooperative_groups;

typedef unsigned short bf16_t;
typedef short bf16x8 __attribute__((ext_vector_type(8)));
typedef float f32x4 __attribute__((ext_vector_type(4)));
typedef unsigned u32x4 __attribute__((ext_vector_type(4)));
typedef unsigned u32x2 __attribute__((ext_vector_type(2)));

constexpr int T = 8192, NCTX = 4096;
constexpr int N_IN = 5808, N_INP = 5888;
constexpr int OFF_ZQ = 0, OFF_ZKV = 384, OFF_ZKPE = 640, OFF_MQ = 672, OFF_MK = 1184, OFF_MV = 1696, OFF_GATE = 2720, OFF_MO = 2736, OFF_BR = 3760;
constexpr int FFN = 2816, TKV = 8704;
constexpr float EPS = 1e-6f;

constexpr size_t OUT_Y = 0;
constexpr size_t OUT_CKV = (size_t)T * 1024;
constexpr size_t OUT_KROPE = OUT_CKV + (size_t)16 * 256 * 256;
constexpr size_t OUT_C = OUT_KROPE + (size_t)16 * 256 * 32;
constexpr size_t OUT_N = OUT_C + (size_t)16 * 2 * 4 * 256 * 128;
constexpr size_t OUT_M = OUT_N + (size_t)16 * 2 * 4 * 128;

constexpr size_t WS_CTRL = 0;
constexpr size_t WS_BAR = 256;
constexpr size_t WS_ROPE = 256 + 16384;
constexpr size_t WS_MOD = WS_ROPE + 4096;
constexpr size_t WS_WIN = WS_MOD + 3 * 6144 * 4;
constexpr size_t WS_WUQ = WS_WIN + (size_t)N_INP * 1024 * 2;
constexpr size_t WS_WUKV = WS_WUQ + (size_t)768 * 384 * 2;
constexpr size_t WS_WOMLA = WS_WUKV + (size_t)1024 * 256 * 2;
constexpr size_t WS_WOMLSTM = WS_WOMLA + (size_t)1024 * 512 * 2;
constexpr size_t WS_WOUT = WS_WOMLSTM + (size_t)1024 * 1024 * 2;
constexpr size_t WS_WFIN = WS_WOUT + (size_t)1024 * 1024 * 2;
constexpr size_t WS_WFOUT = WS_WFIN + (size_t)5632 * 1024 * 2;
constexpr size_t WS_GATES = WS_WFOUT + (size_t)1024 * 2816 * 2;
constexpr size_t WS_GB = WS_GATES + (size_t)T * 16 * 4;
constexpr size_t WS_GL = WS_GB + (size_t)1024 * 64 * 16;
constexpr size_t WS_A = WS_GL + (size_t)1024 * 8;
constexpr size_t WS_Z = WS_A;
constexpr size_t WS_PA1 = WS_A;
constexpr size_t WS_PB1 = WS_A + ((size_t)1 << 25);
constexpr size_t WS_ACT = WS_A;
constexpr size_t WS_PA2 = WS_A + ((size_t)48 << 20);
constexpr size_t WS_B = WS_A + (size_t)T * N_INP * 2;
constexpr size_t WS_C = WS_B + (size_t)T * 1024 * 2;
constexpr size_t WS_QN = WS_C;
constexpr size_t WS_CKV = WS_QN + (size_t)T * 384 * 2;
constexpr size_t WS_KPE = WS_CKV + (size_t)TKV * 256 * 2;
constexpr size_t WS_Q = WS_KPE + (size_t)TKV * 32 * 2;
constexpr size_t WS_KV = WS_Q + (size_t)T * 768 * 2;
constexpr size_t WS_ATT = WS_KV + (size_t)TKV * 1024 * 2;
constexpr size_t WS_X1 = WS_C;
constexpr size_t WS_D = WS_ATT + (size_t)T * 512 * 2;
constexpr size_t WS_HF = WS_D;
constexpr size_t WS_HB = WS_HF + (size_t)T * 1024 * 2;
constexpr size_t WS_T1 = WS_HF;
constexpr size_t WS_PB2 = WS_D;
constexpr size_t WS_HM = WS_HB + (size_t)T * 1024 * 2;
constexpr size_t WS_END = WS_HM + (size_t)T * 1024 * 2;
static_assert((size_t)T * FFN * 2 <= ((size_t)48 << 20), "ACT vs PA2 overlap");
static_assert(WS_PA2 + ((size_t)1 << 25) <= WS_B, "PA2 fits region A");

struct Params {
  const float* x_prompt; const float* x_sample; const float* cache_ckv; const float* cache_krope;
  const float* state_C; const float* state_n; const float* state_m; const float* c; const float* c_ctx;
  const float* w_mod; const float* b_mod; const float* g_norm_mix; const float* w_in; const float* b_gates;
  const float* g_q_norm; const float* w_uq; const float* g_kv_norm; const float* w_ukv; const float* g_mlstm_norm;
  const float* w_o_mla; const float* w_o_mlstm; const float* w_out; const float* g_norm_ffn; const float* w_ffn_in;
  const float* w_ffn_out; const float* g_final;
  float* out; char* ws;
};

__device__ __forceinline__ bf16_t f2bf(float f) { unsigned u = __float_as_uint(f); u += 0x7fffu + ((u >> 16) & 1u); return (bf16_t)(u >> 16); }
__device__ __forceinline__ float bf2f(bf16_t b) { return __uint_as_float(((unsigned)b) << 16); }
__device__ __forceinline__ unsigned pk2(float lo, float hi) { unsigned r; asm("v_cvt_pk_bf16_f32 %0, %1, %2" : "=v"(r) : "v"(lo), "v"(hi)); return r; }
__device__ __forceinline__ float bflo(unsigned w) { return __uint_as_float(w << 16); }
__device__ __forceinline__ float bfhi(unsigned w) { return __uint_as_float(w & 0xffff0000u); }
__device__ __forceinline__ float sigmoidf_(float x) { return __builtin_amdgcn_rcpf(1.f + __expf(-x)); }
__device__ __forceinline__ const float* xrow(const Params& p, int tok) { return tok < NCTX ? p.x_prompt + (size_t)tok * 1024 : p.x_sample + (size_t)(tok - NCTX) * 1024; }
__device__ __forceinline__ int cond_of(int tok) { return tok < NCTX ? 0 : 1 + ((tok - NCTX) >> 11); }
__device__ __forceinline__ int otid() { int t = threadIdx.x; asm volatile("" : "+v"(t)); return t; }
typedef short s16x4 __attribute__((ext_vector_type(4)));
__device__ __forceinline__ bf16x8 tr_pair(const bf16_t* p0, const bf16_t* p1) {
  const unsigned a0 = (unsigned)(size_t)(__attribute__((address_space(3))) const bf16_t*)p0, a1 = (unsigned)(size_t)(__attribute__((address_space(3))) const bf16_t*)p1;
  s16x4 lo, hi;
  asm volatile("ds_read_b64_tr_b16 %0, %2\n\tds_read_b64_tr_b16 %1, %3\n\ts_waitcnt lgkmcnt(0)" : "=&v"(lo), "=&v"(hi) : "v"(a0), "v"(a1) : "memory");
  return (bf16x8){lo[0], lo[1], lo[2], lo[3], hi[0], hi[1], hi[2], hi[3]};
}
template <int O0, int O1, int O2, int O3, int STEP>
__device__ __forceinline__ void tr_frag4(const bf16_t* p, bf16x8& f0, bf16x8& f1, bf16x8& f2, bf16x8& f3) {
  const unsigned a = (unsigned)(size_t)(__attribute__((address_space(3))) const bf16_t*)p;
  s16x4 l0, h0, l1, h1, l2, h2, l3, h3;
  asm volatile("ds_read_b64_tr_b16 %0, %8 offset:%9\n\tds_read_b64_tr_b16 %1, %8 offset:%10\n\tds_read_b64_tr_b16 %2, %8 offset:%11\n\tds_read_b64_tr_b16 %3, %8 offset:%12\n\t"
               "ds_read_b64_tr_b16 %4, %8 offset:%13\n\tds_read_b64_tr_b16 %5, %8 offset:%14\n\tds_read_b64_tr_b16 %6, %8 offset:%15\n\tds_read_b64_tr_b16 %7, %8 offset:%16\n\ts_waitcnt lgkmcnt(0)"
               : "=&v"(l0), "=&v"(h0), "=&v"(l1), "=&v"(h1), "=&v"(l2), "=&v"(h2), "=&v"(l3), "=&v"(h3)
               : "v"(a), "i"(O0), "i"(O0 + STEP), "i"(O1), "i"(O1 + STEP), "i"(O2), "i"(O2 + STEP), "i"(O3), "i"(O3 + STEP) : "memory");
  f0 = (bf16x8){l0[0], l0[1], l0[2], l0[3], h0[0], h0[1], h0[2], h0[3]}; f1 = (bf16x8){l1[0], l1[1], l1[2], l1[3], h1[0], h1[1], h1[2], h1[3]};
  f2 = (bf16x8){l2[0], l2[1], l2[2], l2[3], h2[0], h2[1], h2[2], h2[3]}; f3 = (bf16x8){l3[0], l3[1], l3[2], l3[3], h3[0], h3[1], h3[2], h3[3]};
}
__device__ __forceinline__ float wave_sum(float v) {
#pragma unroll
  for (int o = 32; o >= 1; o >>= 1) v += __shfl_xor(v, o);
  return v;
}

template <class Epi>
__device__ __forceinline__ void gemm_tile(const bf16_t* __restrict__ A, int lda, const bf16_t* __restrict__ Bt, int ldb, int K, int row0, int col0, char* lds, const Epi& epi) {
  bf16_t* As = (bf16_t*)lds; bf16_t* Bs = As + 128 * 72;
  const int tid = otid(), wave = tid >> 6, lane = tid & 63, r16 = lane & 15, g = lane >> 4;
  const int wm = wave >> 2, wn = wave & 3;
  f32x4 acc[4][2];
#pragma unroll
  for (int m = 0; m < 4; ++m)
#pragma unroll
    for (int n = 0; n < 2; ++n) acc[m][n] = (f32x4){0.f, 0.f, 0.f, 0.f};
  const int lr0 = tid >> 3, lk = (tid & 7) * 8;
  const bf16_t* ag0 = A + (size_t)(row0 + lr0) * lda + lk; const bf16_t* ag1 = ag0 + (size_t)64 * lda;
  const bf16_t* bg0 = Bt + (size_t)(col0 + lr0) * ldb + lk; const bf16_t* bg1 = bg0 + (size_t)64 * ldb;
  u32x4 ra0 = *(const u32x4*)ag0, ra1 = *(const u32x4*)ag1, rb0 = *(const u32x4*)bg0, rb1 = *(const u32x4*)bg1;
  const int nk = K >> 6;
  for (int kt = 0; kt < nk; ++kt) {
    __syncthreads();
    *(u32x4*)(As + lr0 * 72 + lk) = ra0; *(u32x4*)(As + (lr0 + 64) * 72 + lk) = ra1;
    *(u32x4*)(Bs + lr0 * 72 + lk) = rb0; *(u32x4*)(Bs + (lr0 + 64) * 72 + lk) = rb1;
    __syncthreads();
    if (kt + 1 < nk) { const int ko = (kt + 1) * 64; ra0 = *(const u32x4*)(ag0 + ko); ra1 = *(const u32x4*)(ag1 + ko); rb0 = *(const u32x4*)(bg0 + ko); rb1 = *(const u32x4*)(bg1 + ko); }
#pragma unroll
    for (int ks = 0; ks < 2; ++ks) {
      bf16x8 af[4], bfr[2];
#pragma unroll
      for (int m = 0; m < 4; ++m) af[m] = *(const bf16x8*)(As + (wm * 64 + m * 16 + r16) * 72 + ks * 32 + g * 8);
#pragma unroll
      for (int n = 0; n < 2; ++n) bfr[n] = *(const bf16x8*)(Bs + (wn * 32 + n * 16 + r16) * 72 + ks * 32 + g * 8);
#pragma unroll
      for (int m = 0; m < 4; ++m)
#pragma unroll
        for (int n = 0; n < 2; ++n) acc[m][n] = __builtin_amdgcn_mfma_f32_16x16x32_bf16(bfr[n], af[m], acc[m][n], 0, 0, 0);
    }
  }
#pragma unroll
  for (int m = 0; m < 4; ++m)
#pragma unroll
    for (int n = 0; n < 2; ++n) epi(row0 + wm * 64 + m * 16 + r16, col0 + wn * 32 + n * 16 + 4 * g, acc[m][n]);
}

template <class Epi>
__device__ __forceinline__ void gemm_phase(const bf16_t* A, int lda, const bf16_t* Bt, int ldb, int M, int N, int K, char* lds, const Epi& epi, int tile_off, int tile_total) {
  const int nrt = M >> 7, nt = nrt * (N >> 7);
  for (int t = blockIdx.x; t < tile_total; t += gridDim.x) {
    const int u = t - tile_off;
    if (u < 0 || u >= nt) continue;
    gemm_tile(A, lda, Bt, ldb, K, (u % nrt) * 128, (u / nrt) * 128, lds, epi);
  }
}


namespace pg8 {
#define PG8_LAS __attribute__((address_space(3)))
constexpr int BM = 256, BK = 64, HALF = 128, HTB = HALF * BK * 2, STAGE_BYTES = 8 * HTB, NXCD = 8, WGM = 8;
__device__ __forceinline__ int lds_byte(int r, int c) { const int st = (r >> 4) * 2 + (c >> 5), rr = r & 15, cc = c & 31, ob = rr * 64 + cc * 2; return st * 1024 + (ob ^ (((ob >> 9) & 1) << 5)); }
__device__ __forceinline__ void stage_rc(int b, int& R, int& C) { const int st = b / 1024, sb = b % 1024, swz = sb ^ (((sb >> 9) & 1) << 5); R = (st >> 1) * 16 + swz / 64; C = (st & 1) * 32 + (swz % 64) / 2; }
__device__ __forceinline__ int perm32(int rho) { const int n = rho >> 4, i = rho & 15; return 8 * (i >> 2) + 4 * n + (i & 3); }
struct Unit { int pm, pn, kpart; };
struct Gemm { const bf16_t* A; const bf16_t* Bt; int lda, ldb, K; };
struct Order {
  int nM, nN, nwg, G, c, parts;
  __device__ void init(int M, int N, int G_, int c_, int parts_) { nM = M / BM; nN = N / BM; nwg = nM * nN; G = G_; c = c_; parts = parts_; }
  __device__ bool next(int i, Unit& u) const {
    const long L = (long)i * G + c; if (L >= (long)nwg * parts) return false;
    u.kpart = (int)(L / nwg); int wgid = (int)(L % nwg);
    { const int q = nwg / NXCD, r = nwg % NXCD, xcd = wgid % NXCD, off = wgid / NXCD; wgid = (xcd < r ? xcd * (q + 1) : r * (q + 1) + (xcd - r) * q) + off; }
    const int nig = WGM * nN, gid = wgid / nig, fm = gid * WGM, gsz = (nM - fm) < WGM ? (nM - fm) : WGM;
    u.pm = fm + ((wgid % nig) % gsz); u.pn = (wgid % nig) / gsz; return true;
  }
};
template <class Epi>
__device__ __forceinline__ void gemm_phase(PG8_LAS unsigned char* lds, const Gemm g, const Order& S, const Epi& E) {
  const int tid = otid(), wid = __builtin_amdgcn_readfirstlane(tid >> 6), lane = tid & 63, wr = wid >> 2, wc = wid & 3, fr = lane & 15, fq = lane >> 4;
  const int K = g.K, nt = K / BK;
  unsigned voffA, voffB;
  { int R, C; stage_rc(tid * 16, R, C); const int Rb = (R & ~31) + perm32(R & 31);
    voffA = (unsigned)(R * g.lda + C) * 2u; voffB = (unsigned)(Rb * g.ldb + C) * 2u; }
  const size_t rskA = (size_t)64 * g.lda * 2, rskB = (size_t)64 * g.ldb * 2;
  const size_t kstep = (size_t)(BK * 2);
  const size_t hstepA = (size_t)HALF * g.lda * 2, hstepB = (size_t)HALF * g.ldb * 2, tstepA = 2 * hstepA, tstepB = 2 * hstepB;
  const unsigned ldsw = (unsigned)wid * 1024u;
  const int aoff = lds_byte(wr * 64 + fr, fq * 8), boff = lds_byte(wc * 32 + fr, fq * 8);
#define PG8_SA(b, h) (((b) * 2 + (h)) * HTB)
#define PG8_SB(b, h) ((4 + (b) * 2 + (h)) * HTB)
#define PG8_STAGE(bufoff, gbase, voff) do { _Pragma("unroll") for (int _i = 0; _i < 2; ++_i) \
    __builtin_amdgcn_global_load_lds((const unsigned*)((const char*)(gbase) + (size_t)_i * rsk_##voff + (voff)), (PG8_LAS unsigned*)(lds + (bufoff) + ldsw + _i * 8192), 16, 0, 0); } while (0)
#define rsk_voffA rskA
#define rsk_voffB rskB
#define PG8_LDA(dst, b, h) do { _Pragma("unroll") for (int m = 0; m < 4; ++m) _Pragma("unroll") for (int k = 0; k < 2; ++k) dst[m][k] = *(const PG8_LAS bf16x8*)(lds + PG8_SA(b, h) + aoff + m * 2048 + k * 1024); } while (0)
#define PG8_LDB(dst, b, h) do { _Pragma("unroll") for (int n = 0; n < 2; ++n) _Pragma("unroll") for (int k = 0; k < 2; ++k) dst[n][k] = *(const PG8_LAS bf16x8*)(lds + PG8_SB(b, h) + boff + n * 2048 + k * 1024); } while (0)
#define PG8_MMA(ai, bj, At, Bt) do { __builtin_amdgcn_s_setprio(1); _Pragma("unroll") for (int m = 0; m < 4; ++m) _Pragma("unroll") for (int n = 0; n < 2; ++n) _Pragma("unroll") for (int k = 0; k < 2; ++k) \
    acc[ai][bj][m][n] = __builtin_amdgcn_mfma_f32_16x16x32_bf16(Bt[n][k], At[m][k], acc[ai][bj][m][n], 0, 0, 0); __builtin_amdgcn_s_setprio(0); } while (0)
#define PG8_WAIT_V(n) asm volatile("s_waitcnt vmcnt(" #n ")" ::: "memory")
#define PG8_WAIT_L(n) asm volatile("s_waitcnt lgkmcnt(" #n ")" ::: "memory")
#define PG8_BAR __builtin_amdgcn_s_barrier()
#define PG8_SCHED __builtin_amdgcn_sched_barrier(0)
  Unit cur, nxt; int ui = 0;
  if (!S.next(0, cur)) return;
  f32x4 acc[2][2][4][2];
#pragma unroll
  for (int a = 0; a < 2; ++a)
#pragma unroll
    for (int b = 0; b < 2; ++b)
#pragma unroll
      for (int m = 0; m < 4; ++m)
#pragma unroll
        for (int n = 0; n < 2; ++n) acc[a][b][m][n] = (f32x4){0.f, 0.f, 0.f, 0.f};
  bf16x8 At[4][2], B0[2][2], B1[2][2];
  const char* cA = (const char*)g.A + (size_t)cur.pm * tstepA + (size_t)cur.kpart * K * 2; const char* cB = (const char*)g.Bt + (size_t)cur.pn * tstepB + (size_t)cur.kpart * K * 2;
  PG8_STAGE(PG8_SB(0, 0), cB, voffB); PG8_STAGE(PG8_SB(0, 1), cB + hstepB, voffB); PG8_STAGE(PG8_SA(0, 0), cA, voffA); PG8_STAGE(PG8_SA(0, 1), cA + hstepA, voffA);
  if (wr == 1) PG8_BAR;
  PG8_WAIT_V(2); PG8_BAR;
  PG8_STAGE(PG8_SB(1, 0), cB + kstep, voffB); PG8_STAGE(PG8_SA(1, 0), cA + kstep, voffA); PG8_STAGE(PG8_SB(1, 1), cB + hstepB + kstep, voffB);
  PG8_WAIT_V(6); PG8_BAR;
  for (;;) {
    const bool has_next = S.next(ui + 1, nxt);
    const char* nA = has_next ? (const char*)g.A + (size_t)nxt.pm * tstepA + (size_t)nxt.kpart * K * 2 : cA; const char* nB = has_next ? (const char*)g.Bt + (size_t)nxt.pn * tstepB + (size_t)nxt.kpart * K * 2 : cB;
    for (int t = 0; t < nt; t += 2) {
      const bool last = (t == nt - 2);
      const char* a1 = cA + (size_t)(t + 1) * kstep;
      const char* a2 = last ? nA : cA + (size_t)(t + 2) * kstep; const char* b2 = last ? nB : cB + (size_t)(t + 2) * kstep;
      const char* a3 = a2 + kstep; const char* b3 = b2 + kstep;
      PG8_LDB(B0, 0, 0); PG8_LDB(B1, 0, 1); PG8_SCHED; PG8_LDA(At, 0, 0); PG8_STAGE(PG8_SA(1, 1), a1 + hstepA, voffA);
      PG8_WAIT_V(8); PG8_WAIT_L(0); PG8_BAR; PG8_MMA(0, 0, At, B0); PG8_MMA(0, 1, At, B1); PG8_BAR; PG8_SCHED;
      PG8_LDA(At, 0, 1); PG8_STAGE(PG8_SB(0, 0), b2, voffB); PG8_STAGE(PG8_SB(0, 1), b2 + hstepB, voffB); PG8_STAGE(PG8_SA(0, 0), a2, voffA);
      PG8_WAIT_V(8); PG8_WAIT_L(0); PG8_BAR; PG8_MMA(1, 0, At, B0); PG8_MMA(1, 1, At, B1); PG8_BAR; PG8_SCHED;
      PG8_LDB(B0, 1, 0); PG8_LDB(B1, 1, 1); PG8_SCHED; PG8_LDA(At, 1, 0); PG8_STAGE(PG8_SA(0, 1), a2 + hstepA, voffA);
      PG8_WAIT_V(8); PG8_WAIT_L(0); PG8_BAR; PG8_MMA(0, 0, At, B0); PG8_MMA(0, 1, At, B1); PG8_BAR; PG8_SCHED;
      PG8_LDA(At, 1, 1); PG8_STAGE(PG8_SB(1, 0), b3, voffB); PG8_STAGE(PG8_SB(1, 1), b3 + hstepB, voffB); PG8_STAGE(PG8_SA(1, 0), a3, voffA);
      PG8_WAIT_V(8); PG8_WAIT_L(0); PG8_BAR; PG8_MMA(1, 0, At, B0); PG8_MMA(1, 1, At, B1); PG8_BAR; PG8_SCHED;
    }
    if (wr == 0) PG8_BAR;
    { const int l2_ = otid() & 63; E(acc, cur, wr, wc, l2_ & 15, l2_ >> 4); }
    if (!has_next) break;
#pragma unroll
    for (int a = 0; a < 2; ++a)
#pragma unroll
      for (int b = 0; b < 2; ++b)
#pragma unroll
        for (int m = 0; m < 4; ++m)
#pragma unroll
          for (int n = 0; n < 2; ++n) acc[a][b][m][n] = (f32x4){0.f, 0.f, 0.f, 0.f};
    cur = nxt; cA = nA; cB = nB; ++ui;
    if (wr == 1) PG8_BAR;
  }
  PG8_WAIT_V(0);
  PG8_BAR;
#undef PG8_SA
#undef PG8_SB
#undef PG8_STAGE
#undef rsk_voffA
#undef rsk_voffB
#undef PG8_LDA
#undef PG8_LDB
#undef PG8_MMA
#undef PG8_WAIT_V
#undef PG8_WAIT_L
#undef PG8_BAR
#undef PG8_SCHED
}
}
template <class F> struct EpiAd { F f;
  __device__ __forceinline__ void operator()(const f32x4 (&acc)[2][2][4][2], const pg8::Unit& u, int wr, int wc, int fr, int fq) const {
#pragma unroll
    for (int ai = 0; ai < 2; ++ai)
#pragma unroll
      for (int m = 0; m < 4; ++m) { const int row = u.pm * 256 + ai * 128 + wr * 64 + m * 16 + fr;
#pragma unroll
        for (int bj = 0; bj < 2; ++bj)
        { f(row, u.pn * 256 + bj * 128 + wc * 32 + 8 * fq, acc[ai][bj][m][0], acc[ai][bj][m][1], u.kpart); asm volatile("" ::: "memory"); }
        asm volatile("" ::: "memory"); }
  } };
template <class F>
__device__ __forceinline__ void big_gemm(PG8_LAS unsigned char* lds, const bf16_t* A, int lda, const bf16_t* Bt, int ldb, int M, int N, int Kpart, int parts, int c0, const F& f) {
  pg8::Gemm g{A, Bt, lda, ldb, Kpart}; pg8::Order S; S.init(M, N, (int)gridDim.x, (int)((blockIdx.x + c0) % gridDim.x), parts);
  EpiAd<F> E{f}; pg8::gemm_phase<EpiAd<F>>(lds, g, S, E);
}

__device__ __forceinline__ u32x4 pk8(f32x4 a, f32x4 b) { u32x4 w; w.x = pk2(a[0], a[1]); w.y = pk2(a[2], a[3]); w.z = pk2(b[0], b[1]); w.w = pk2(b[2], b[3]); return w; }
struct EpiZ { bf16_t* Z; float* gates; const float* b_gates;
  __device__ __forceinline__ void operator()(int row, int col, f32x4 v0, f32x4 v1, int kp = 0) const {
    *(u32x4*)(Z + (size_t)row * N_INP + col) = pk8(v0, v1);
    if (col >= OFF_GATE && col < OFF_GATE + 16) { const int c = col - OFF_GATE; *(f32x4*)(gates + (size_t)row * 16 + c) = v0 + *(const f32x4*)(b_gates + c); *(f32x4*)(gates + (size_t)row * 16 + c + 4) = v1 + *(const f32x4*)(b_gates + c + 4); }
  } };
struct EpiQ { bf16_t* Q; const float* rope;
  __device__ __forceinline__ f32x4 rot(int row, int col, f32x4 v) const {
    const int r = col % 96;
    if (r >= 64 && row >= NCTX) {
      const int pp = r - 64, hf = pp >> 4, i0 = (pp & 15) >> 1; const int n = (row - NCTX) & 2047; const int pos = hf ? (n & 63) : (n >> 6);
      const f32x4 cs = *(const f32x4*)(rope + (pos * 8 + i0) * 2);
      v = (f32x4){v[0] * cs[0] - v[1] * cs[1], v[0] * cs[1] + v[1] * cs[0], v[2] * cs[2] - v[3] * cs[3], v[2] * cs[3] + v[3] * cs[2]};
    }
    return v;
  }
  __device__ __forceinline__ void operator()(int row, int col, f32x4 v0, f32x4 v1, int kp = 0) const { *(u32x4*)(Q + (size_t)row * 768 + col) = pk8(rot(row, col, v0), rot(row, col + 4, v1)); } };
struct EpiBf { bf16_t* O; int ldc;
  __device__ __forceinline__ void operator()(int row, int col, f32x4 v0, f32x4 v1, int kp = 0) const { *(u32x4*)(O + (size_t)row * ldc + col) = pk8(v0, v1); } };
__device__ __forceinline__ f32x4 sig4lo(u32x4 z) { return (f32x4){sigmoidf_(bflo(z.x)), sigmoidf_(bfhi(z.x)), sigmoidf_(bflo(z.y)), sigmoidf_(bfhi(z.y))}; }
__device__ __forceinline__ f32x4 sig4hi(u32x4 z) { return (f32x4){sigmoidf_(bflo(z.z)), sigmoidf_(bfhi(z.z)), sigmoidf_(bflo(z.w)), sigmoidf_(bfhi(z.w))}; }
struct EpiT1 { bf16_t* T1; const bf16_t* Z;
  __device__ __forceinline__ void operator()(int row, int col, f32x4 v0, f32x4 v1, int kp = 0) const {
    const u32x4 zz = *(const u32x4*)(Z + (size_t)row * N_INP + OFF_BR + col);
    *(u32x4*)(T1 + (size_t)row * 1024 + col) = pk8(v0 * sig4lo(zz), v1 * sig4hi(zz));
  } };
struct EpiMG { const bf16_t* T1; const bf16_t* Z; bf16_t* MG;
  __device__ __forceinline__ void operator()(int row, int col, f32x4 v0, f32x4 v1, int kp = 0) const {
    const u32x4 zz = *(const u32x4*)(Z + (size_t)row * N_INP + OFF_BR + 1024 + col);
    const u32x4 t = *(const u32x4*)(T1 + (size_t)row * 1024 + col);
    const f32x4 t0 = {bflo(t.x), bfhi(t.x), bflo(t.y), bfhi(t.y)}, t1 = {bflo(t.z), bfhi(t.z), bflo(t.w), bfhi(t.w)};
    *(u32x4*)(MG + (size_t)row * 1024 + col) = pk8(t0 + v0 * sig4lo(zz), t1 + v1 * sig4hi(zz));
  } };
struct EpiPart { bf16_t* P0; bf16_t* P1;
  __device__ __forceinline__ void operator()(int row, int col, f32x4 v0, f32x4 v1, int kp = 0) const { *(u32x4*)((kp ? P1 : P0) + (size_t)row * 1024 + col) = pk8(v0, v1); } };
struct EpiAct { bf16_t* ACT;
  __device__ __forceinline__ void operator()(int row, int hcol, f32x4 a0, f32x4 a1, f32x4 u0, f32x4 u1) const {
    f32x4 o0, o1;
#pragma unroll
    for (int i = 0; i < 4; ++i) { o0[i] = a0[i] * sigmoidf_(a0[i]) * u0[i]; o1[i] = a1[i] * sigmoidf_(a1[i]) * u1[i]; }
    *(u32x4*)(ACT + (size_t)row * FFN + hcol) = pk8(o0, o1);
  } };

__device__ __forceinline__ int map_col(int wid, int n) {
  if (wid == 0) return n < N_IN ? n : -1;
  if (wid == 1) { const int h = n / 96, r = n % 96; if (r < 64) return n; const int pp = r - 64; return h * 96 + 64 + (pp >> 4) * 16 + (pp & 1) * 8 + ((pp & 15) >> 1); }
  if (wid == 6) return ((n >> 7) & 1) * FFN + (n >> 8) * 128 + (n & 127);
  return n;
}

__device__ void phase_prologue(const Params& p, char* lds) {
  const int tid = otid();
  float* fl = (float*)lds;
  if (blockIdx.x == 0) {
    if (tid == 0) { unsigned* ctrl = (unsigned*)(p.ws + WS_CTRL); ctrl[0] = 0u; }
    if (tid < 8) {
      double th = 1.0; for (int k = 0; k < tid; ++k) th *= 0.31622776601683794;
      double x2 = th * th, s = th, c = 1.0, ts = th, tc = 1.0;
      for (int k = 1; k <= 12; ++k) { tc = -tc * x2 / (double)((2 * k - 1) * (2 * k)); c += tc; ts = -ts * x2 / (double)((2 * k) * (2 * k + 1)); s += ts; }
      double cc = 1.0, ss = 0.0; float* rope = (float*)(p.ws + WS_ROPE);
      for (int pos = 0; pos < 64; ++pos) { rope[(pos * 8 + tid) * 2] = (float)cc; rope[(pos * 8 + tid) * 2 + 1] = (float)ss; const double nc = cc * c - ss * s, ns = ss * c + cc * s; cc = nc; ss = ns; }
    }
  }
  if (blockIdx.x < 192) {
    const int q = tid & 7, ks = tid >> 3; const int col = blockIdx.x * 32 + q * 4;
    f32x4 a0 = {0, 0, 0, 0}, a1 = a0, a2 = a0;
#pragma unroll 4
    for (int i = 0; i < 16; ++i) {
      const int k = ks * 16 + i;
      const f32x4 w = __builtin_nontemporal_load((const f32x4*)(p.w_mod + (size_t)k * 6144 + col));
      float c0 = p.c_ctx[k], c1 = p.c[k], c2 = p.c[1024 + k];
      c0 = c0 * sigmoidf_(c0); c1 = c1 * sigmoidf_(c1); c2 = c2 * sigmoidf_(c2);
      a0 += w * c0; a1 += w * c1; a2 += w * c2;
    }
    float* r = fl + (ks * 8 + q) * 12;
    *(f32x4*)(r) = a0; *(f32x4*)(r + 4) = a1; *(f32x4*)(r + 8) = a2;
    __syncthreads();
    if (tid < 96) {
      const int qq = tid / 12, e = tid % 12; float s = 0.f;
      for (int k2 = 0; k2 < 64; ++k2) s += fl[(k2 * 8 + qq) * 12 + e];
      const int cc = e >> 2, i = e & 3, cl = blockIdx.x * 32 + qq * 4 + i;
      ((float*)(p.ws + WS_MOD))[cc * 6144 + cl] = s + p.b_mod[cl];
    }
    __syncthreads();
  }
  constexpr int NT0 = 16 * 92, NT1 = 6 * 12, NT2 = 4 * 16, NT3 = 8 * 16, NT4 = 16 * 16, NT5 = 16 * 16, NT6 = 16 * 88, NT7 = 44 * 16;
  constexpr int TOT = NT0 + NT1 + NT2 + NT3 + NT4 + NT5 + NT6 + NT7;
  for (int t = blockIdx.x; t < TOT; t += gridDim.x) {
    int wid, u = t; const float* W; int K, N; bf16_t* Wt;
    if (u < NT0) { wid = 0; W = p.w_in; K = 1024; N = N_IN; Wt = (bf16_t*)(p.ws + WS_WIN); }
    else if ((u -= NT0) < NT1) { wid = 1; W = p.w_uq; K = 384; N = 768; Wt = (bf16_t*)(p.ws + WS_WUQ); }
    else if ((u -= NT1) < NT2) { wid = 2; W = p.w_ukv; K = 256; N = 1024; Wt = (bf16_t*)(p.ws + WS_WUKV); }
    else if ((u -= NT2) < NT3) { wid = 3; W = p.w_o_mla; K = 512; N = 1024; Wt = (bf16_t*)(p.ws + WS_WOMLA); }
    else if ((u -= NT3) < NT4) { wid = 4; W = p.w_o_mlstm; K = 1024; N = 1024; Wt = (bf16_t*)(p.ws + WS_WOMLSTM); }
    else if ((u -= NT4) < NT5) { wid = 5; W = p.w_out; K = 1024; N = 1024; Wt = (bf16_t*)(p.ws + WS_WOUT); }
    else if ((u -= NT5) < NT6) { wid = 6; W = p.w_ffn_in; K = 1024; N = 5632; Wt = (bf16_t*)(p.ws + WS_WFIN); }
    else { u -= NT6; wid = 7; W = p.w_ffn_out; K = 2816; N = 1024; Wt = (bf16_t*)(p.ws + WS_WFOUT); }
    const int nkt = K >> 6; const int kt = u % nkt, nt = u / nkt;
    {
      typedef float f32x2v __attribute__((ext_vector_type(2)));
      const int n4 = (tid & 15) * 4; const int n = nt * 64 + n4;
      const float scale = (wid == 0 && n >= OFF_MK && n < OFF_MK + 512) ? 0.08838834764831845f : 1.0f;
#pragma unroll
      for (int i = 0; i < 2; ++i) { const int k = (tid >> 4) + 32 * i; const float* wr_ = W + (size_t)(kt * 64 + k) * N; f32x4 v;
        if (wid == 6) v = __builtin_nontemporal_load((const f32x4*)(wr_ + map_col(6, n)));
        else if (wid == 1 && (n % 96) >= 64) { const int s0 = map_col(1, n), s1 = map_col(1, n + 1); const f32x2v x1 = *(const f32x2v*)(wr_ + s0), x2 = *(const f32x2v*)(wr_ + s1); v = (f32x4){x1[0], x2[0], x1[1], x2[1]}; }
        else if (wid == 0 && n >= N_IN) v = (f32x4){0.f, 0.f, 0.f, 0.f};
        else v = __builtin_nontemporal_load((const f32x4*)(wr_ + n));
        v = v * scale;
        fl[k * 65 + n4] = v[0]; fl[k * 65 + n4 + 1] = v[1]; fl[k * 65 + n4 + 2] = v[2]; fl[k * 65 + n4 + 3] = v[3]; }
    }
    __syncthreads();
    {
      const int nl = tid >> 3, k8 = (tid & 7) * 8; u32x4 w;
      w.x = pk2(fl[(k8 + 0) * 65 + nl], fl[(k8 + 1) * 65 + nl]); w.y = pk2(fl[(k8 + 2) * 65 + nl], fl[(k8 + 3) * 65 + nl]);
      w.z = pk2(fl[(k8 + 4) * 65 + nl], fl[(k8 + 5) * 65 + nl]); w.w = pk2(fl[(k8 + 6) * 65 + nl], fl[(k8 + 7) * 65 + nl]);
      *(u32x4*)(Wt + (size_t)(nt * 64 + nl) * K + kt * 64 + k8) = w;
    }
    __syncthreads();
  }
}

__device__ __forceinline__ void unpk8(u32x4 w, f32x4& a, f32x4& b) { a = (f32x4){bflo(w.x), bfhi(w.x), bflo(w.y), bfhi(w.y)}; b = (f32x4){bflo(w.z), bfhi(w.z), bflo(w.w), bfhi(w.w)}; }
__device__ void phase_norm_mod(const Params& p, const bf16_t* PA, const bf16_t* PB, int gi, bf16_t* Xout, const float* g, int ish, int isc, bf16_t* H) {
  const int tid_ = otid(); const int wave = tid_ >> 6, lane = tid_ & 63; const float* mod = (const float*)(p.ws + WS_MOD);
  for (int tok = blockIdx.x * 8 + wave; tok < T; tok += gridDim.x * 8) {
    const float* xr = xrow(p, tok); const int cd = cond_of(tok);
    f32x4 v[4]; float ss = 0.f;
#pragma unroll
    for (int i = 0; i < 2; ++i) { const int col = i * 512 + lane * 8; v[2 * i] = __builtin_nontemporal_load((const f32x4*)(xr + col)); v[2 * i + 1] = __builtin_nontemporal_load((const f32x4*)(xr + col + 4));
      if (PA) { f32x4 a0, a1, b0, b1; unpk8(__builtin_nontemporal_load((const u32x4*)(PA + (size_t)tok * 1024 + col)), a0, a1); unpk8(__builtin_nontemporal_load((const u32x4*)(PB + (size_t)tok * 1024 + col)), b0, b1);
        const f32x4 gt0 = *(const f32x4*)(mod + (cd * 6 + gi) * 1024 + col), gt1 = *(const f32x4*)(mod + (cd * 6 + gi) * 1024 + col + 4);
        v[2 * i] = v[2 * i] + gt0 * (a0 + b0); v[2 * i + 1] = v[2 * i + 1] + gt1 * (a1 + b1);
        *(u32x4*)(Xout + (size_t)tok * 1024 + col) = pk8(v[2 * i], v[2 * i + 1]); }
#pragma unroll
      for (int h2 = 0; h2 < 2; ++h2) { const f32x4 t = v[2 * i + h2]; ss += t[0] * t[0] + t[1] * t[1] + t[2] * t[2] + t[3] * t[3]; } }
    ss = wave_sum(ss); const float rstd = rsqrtf(ss * (1.f / 1024.f) + EPS);
#pragma unroll
    for (int i = 0; i < 2; ++i) { const int col = i * 512 + lane * 8; f32x4 o[2];
#pragma unroll
      for (int h2 = 0; h2 < 2; ++h2) { const int c = col + 4 * h2; const f32x4 gg = *(const f32x4*)(g + c), sc = *(const f32x4*)(mod + (cd * 6 + isc) * 1024 + c), sh = *(const f32x4*)(mod + (cd * 6 + ish) * 1024 + c);
        o[h2] = v[2 * i + h2] * rstd * gg * (sc + 1.f) + sh; }
      *(u32x4*)(H + (size_t)tok * 1024 + col) = pk8(o[0], o[1]); }
  }
}
__device__ void phase_final_norm(const Params& p) {
  const int tid_ = otid(); const int wave = tid_ >> 6, lane = tid_ & 63; const bf16_t* X1 = (const bf16_t*)(p.ws + WS_X1); const bf16_t* PA = (const bf16_t*)(p.ws + WS_PA2); const bf16_t* PB = (const bf16_t*)(p.ws + WS_PB2);
  const float* mod = (const float*)(p.ws + WS_MOD);
  for (int tok = blockIdx.x * 8 + wave; tok < T; tok += gridDim.x * 8) {
    const int cd = cond_of(tok); f32x4 v[4]; float ss = 0.f;
#pragma unroll
    for (int i = 0; i < 2; ++i) { const int col = i * 512 + lane * 8; const size_t o = (size_t)tok * 1024 + col;
      f32x4 x0, x1, a0, a1, b0, b1; unpk8(__builtin_nontemporal_load((const u32x4*)(X1 + o)), x0, x1); unpk8(__builtin_nontemporal_load((const u32x4*)(PA + o)), a0, a1); unpk8(__builtin_nontemporal_load((const u32x4*)(PB + o)), b0, b1);
      const f32x4 gt0 = *(const f32x4*)(mod + (cd * 6 + 5) * 1024 + col), gt1 = *(const f32x4*)(mod + (cd * 6 + 5) * 1024 + col + 4);
      v[2 * i] = x0 + gt0 * (a0 + b0); v[2 * i + 1] = x1 + gt1 * (a1 + b1);
#pragma unroll
      for (int h2 = 0; h2 < 2; ++h2) { const f32x4 t = v[2 * i + h2]; ss += t[0] * t[0] + t[1] * t[1] + t[2] * t[2] + t[3] * t[3]; } }
    ss = wave_sum(ss); const float rstd = rsqrtf(ss * (1.f / 1024.f) + EPS);
#pragma unroll
    for (int i = 0; i < 2; ++i)
#pragma unroll
      for (int h2 = 0; h2 < 2; ++h2) { const int c = i * 512 + lane * 8 + 4 * h2; const f32x4 gg = *(const f32x4*)(p.g_final + c); __builtin_nontemporal_store(v[2 * i + h2] * rstd * gg, (f32x4*)(p.out + OUT_Y + (size_t)tok * 1024 + c)); }
  }
}
__device__ void phase_prep(const Params& p) {
  const int tid_ = otid(); const int wave = tid_ >> 6, lane = tid_ & 63;
  const bf16_t* Z = (const bf16_t*)(p.ws + WS_Z); bf16_t* QN = (bf16_t*)(p.ws + WS_QN); bf16_t* CKV = (bf16_t*)(p.ws + WS_CKV); bf16_t* KPE = (bf16_t*)(p.ws + WS_KPE);
  const float* rope = (const float*)(p.ws + WS_ROPE);
  for (int tok = blockIdx.x * 8 + wave; tok < TKV + 1024; tok += gridDim.x * 8) {
    if (tok >= TKV) {
      const int gidx = tok - TKV; int grp, chain, c;
      if (gidx < 512) { grp = 1; chain = gidx >> 5; c = gidx & 31; } else { grp = 0; chain = (gidx - 512) >> 2; c = gidx & 3; }
      const int b = chain >> 3, dir = (chain >> 2) & 1, h = chain & 3; const int base = grp ? NCTX + b * 2048 : b * 256, S = grp ? 2048 : 256;
      const int posl = c * 64 + lane; const int tk = base + (dir ? S - 1 - posl : posl);
      const float* gp = (const float*)(p.ws + WS_GATES) + (size_t)tk * 16; const float ig = gp[dir * 4 + h], fp = gp[8 + dir * 4 + h];
      const float lf = fminf(fp, 0.f) - log1pf(__expf(-fabsf(fp)));
      float bc = lf;
#pragma unroll
      for (int o2 = 1; o2 < 64; o2 <<= 1) { const float t2 = __shfl_up(bc, o2); if (lane >= o2) bc += t2; }
      const float a = ig - bc; float pm = a;
#pragma unroll
      for (int o2 = 1; o2 < 64; o2 <<= 1) { const float t2 = __shfl_up(pm, o2); if (lane >= o2) pm = fmaxf(pm, t2); }
      *(f32x4*)((float*)(p.ws + WS_GB) + ((size_t)gidx * 64 + lane) * 4) = (f32x4){bc, a, pm, 0.f};
      if (lane == 63) { typedef float f32x2 __attribute__((ext_vector_type(2))); *(f32x2*)((float*)(p.ws + WS_GL) + (size_t)gidx * 2) = (f32x2){bc, pm}; }
      continue;
    }
    if (tok < T) {
      const bf16_t* zr = Z + (size_t)tok * N_INP;
      {
        float v[6]; float ss = 0.f;
#pragma unroll
        for (int i = 0; i < 3; ++i) { const unsigned w = *(const unsigned*)(zr + OFF_ZQ + i * 128 + lane * 2); v[2 * i] = bflo(w); v[2 * i + 1] = bfhi(w); ss += v[2 * i] * v[2 * i] + v[2 * i + 1] * v[2 * i + 1]; }
        ss = wave_sum(ss); const float rstd = rsqrtf(ss * (1.f / 384.f) + EPS);
#pragma unroll
        for (int i = 0; i < 3; ++i) { const int col = i * 128 + lane * 2; *(unsigned*)(QN + (size_t)tok * 384 + col) = pk2(v[2 * i] * rstd * p.g_q_norm[col], v[2 * i + 1] * rstd * p.g_q_norm[col + 1]); }
      }
      {
        const u32x2 w = *(const u32x2*)(zr + OFF_ZKV + lane * 4); float v0 = bflo(w.x), v1 = bfhi(w.x), v2 = bflo(w.y), v3 = bfhi(w.y);
        float ss = wave_sum(v0 * v0 + v1 * v1 + v2 * v2 + v3 * v3); const float rstd = rsqrtf(ss * (1.f / 256.f) + EPS);
        const f32x4 gg = *(const f32x4*)(p.g_kv_norm + lane * 4); const f32x4 o = {v0 * rstd * gg[0], v1 * rstd * gg[1], v2 * rstd * gg[2], v3 * rstd * gg[3]};
        u32x2 ow; ow.x = pk2(o[0], o[1]); ow.y = pk2(o[2], o[3]); *(u32x2*)(CKV + (size_t)tok * 256 + lane * 4) = ow;
        if (tok < NCTX) *(f32x4*)(p.out + OUT_CKV + (size_t)tok * 256 + lane * 4) = o;
      }
      if (lane < 16) {
        const int hf = lane >> 3, i = lane & 7; float x1 = bf2f(zr[OFF_ZKPE + hf * 16 + i]), x2 = bf2f(zr[OFF_ZKPE + hf * 16 + 8 + i]);
        if (tok < NCTX) { p.out[OUT_KROPE + (size_t)tok * 32 + hf * 16 + i] = x1; p.out[OUT_KROPE + (size_t)tok * 32 + hf * 16 + 8 + i] = x2; }
        else { const int n = (tok - NCTX) & 2047; const int pos = hf ? (n & 63) : (n >> 6); const float cs = rope[(pos * 8 + i) * 2], sn = rope[(pos * 8 + i) * 2 + 1];
          const float y1 = x1 * cs - x2 * sn, y2 = x1 * sn + x2 * cs; x1 = y1; x2 = y2; }
        *(unsigned*)(KPE + (size_t)tok * 32 + hf * 16 + 2 * i) = pk2(x1, x2);
      }
    } else {
      const int r = tok - T;
      const f32x4 cv = *(const f32x4*)(p.cache_ckv + (size_t)r * 256 + lane * 4); u32x2 ow; ow.x = pk2(cv[0], cv[1]); ow.y = pk2(cv[2], cv[3]);
      *(u32x2*)(CKV + (size_t)tok * 256 + lane * 4) = ow;
      if (lane < 16) { const int hf = lane >> 3, i = lane & 7; const float x1 = p.cache_krope[(size_t)r * 32 + hf * 16 + i], x2 = p.cache_krope[(size_t)r * 32 + hf * 16 + 8 + i];
        *(unsigned*)(KPE + (size_t)tok * 32 + hf * 16 + 2 * i) = pk2(x1, x2); }
    }
  }
}
__device__ void phase_hm(const Params& p) {
  const int tid_ = otid(); const int wave = tid_ >> 6, lane = tid_ & 63;
  const bf16_t* Z = (const bf16_t*)(p.ws + WS_Z); const bf16_t* HF = (const bf16_t*)(p.ws + WS_HF); const bf16_t* HB = (const bf16_t*)(p.ws + WS_HB); bf16_t* HM = (bf16_t*)(p.ws + WS_HM);
  for (int tok = blockIdx.x * 8 + wave; tok < T; tok += gridDim.x * 8) {
    const int col = lane * 16; float v[16]; float ss = 0.f;
#pragma unroll
    for (int i = 0; i < 2; ++i) { const u32x4 a = __builtin_nontemporal_load((const u32x4*)(HF + (size_t)tok * 1024 + col + i * 8)), b = __builtin_nontemporal_load((const u32x4*)(HB + (size_t)tok * 1024 + col + i * 8));
#pragma unroll
      for (int j = 0; j < 4; ++j) { v[i * 8 + 2 * j] = bflo(a[j]) + bflo(b[j]); v[i * 8 + 2 * j + 1] = bfhi(a[j]) + bfhi(b[j]); } }
#pragma unroll
    for (int i = 0; i < 16; ++i) ss += v[i] * v[i];
    ss += __shfl_xor(ss, 1); ss += __shfl_xor(ss, 2); ss += __shfl_xor(ss, 4); ss += __shfl_xor(ss, 8);
    const float rstd = rsqrtf(ss * (1.f / 256.f) + EPS);
#pragma unroll
    for (int i = 0; i < 2; ++i) { const u32x4 zo = __builtin_nontemporal_load((const u32x4*)(Z + (size_t)tok * N_INP + OFF_MO + col + i * 8)); u32x4 w;
#pragma unroll
      for (int j = 0; j < 4; ++j) { const int cc = col + i * 8 + 2 * j;
        w[j] = pk2(v[i * 8 + 2 * j] * rstd * p.g_mlstm_norm[cc] * sigmoidf_(bflo(zo[j])), v[i * 8 + 2 * j + 1] * rstd * p.g_mlstm_norm[cc + 1] * sigmoidf_(bfhi(zo[j]))); }
      *(u32x4*)(HM + (size_t)tok * 1024 + col + i * 8) = w; }
  }
}

__device__ void attn_item(const Params& p, int grp, int b, int h, int qb, char* lds) {
  const int tid = otid(), wave = tid >> 6, lane = tid & 63, r16 = lane & 15, g = lane >> 4;
  bf16_t* Ks = (bf16_t*)lds;
  bf16_t* Vs = Ks + 64 * 104;
  const bf16_t* Q = (const bf16_t*)(p.ws + WS_Q); const bf16_t* KV = (const bf16_t*)(p.ws + WS_KV); const bf16_t* KPE = (const bf16_t*)(p.ws + WS_KPE); bf16_t* ATT = (bf16_t*)(p.ws + WS_ATT);
  const int row0 = (grp ? NCTX + b * 2048 : b * 256) + qb * 256; const int ntile = grp ? 36 : 4;
  bf16x8 qf[2][3];
#pragma unroll
  for (int sb = 0; sb < 2; ++sb)
#pragma unroll
    for (int ks = 0; ks < 3; ++ks) qf[sb][ks] = *(const bf16x8*)(Q + (size_t)(row0 + wave * 32 + sb * 16 + r16) * 768 + h * 96 + ks * 32 + g * 8);
  const float cscale = 0.10206207261596575f * 1.4426950408889634f;
  float m_run[2] = {-1e30f, -1e30f}, l_run[2] = {0.f, 0.f}; f32x4 o[2][4];
#pragma unroll
  for (int sb = 0; sb < 2; ++sb)
#pragma unroll
    for (int i = 0; i < 4; ++i) o[sb][i] = (f32x4){0.f, 0.f, 0.f, 0.f};
  const int kkey0 = tid / 12, kch0 = tid % 12, kc1 = tid < 256 ? tid + 512 : tid, kkey1 = kc1 / 12, kch1 = kc1 % 12, vkey = tid >> 3, vc0 = (tid & 7) * 8;
  u32x4 rk0, rk1 = {0u, 0u, 0u, 0u}, rv;
  const int kb0 = grp ? NCTX + b * 2048 : b * 256, kbc = T + b * 256;
  const bf16_t* pk0 = kch0 < 8 ? KV + (size_t)(kb0 + kkey0) * 1024 + h * 128 + kch0 * 8 : KPE + (size_t)(kb0 + kkey0) * 32 + (kch0 - 8) * 8;
  const bf16_t* pk1 = kch1 < 8 ? KV + (size_t)(kb0 + kkey1) * 1024 + h * 128 + kch1 * 8 : KPE + (size_t)(kb0 + kkey1) * 32 + (kch1 - 8) * 8;
  const bf16_t* pv = KV + (size_t)(kb0 + vkey) * 1024 + h * 128 + 64 + vc0;
  const int st0 = kch0 < 8 ? 64 * 1024 : 64 * 32, st1 = kch1 < 8 ? 64 * 1024 : 64 * 32;
#define ATT_LOAD() do { rk0 = *(const u32x4*)pk0; rk1 = *(const u32x4*)pk1; rv = *(const u32x4*)pv; } while (0)
#define ATT_ADV(ktn) do { if ((ktn) == 32) { const int d_ = kbc - kb0 - 31 * 64; pk0 += (kch0 < 8 ? (ptrdiff_t)d_ * 1024 : (ptrdiff_t)d_ * 32); pk1 += (kch1 < 8 ? (ptrdiff_t)d_ * 1024 : (ptrdiff_t)d_ * 32); pv += (ptrdiff_t)d_ * 1024; } \
    else { pk0 += st0; pk1 += st1; pv += 64 * 1024; } } while (0)
  ATT_LOAD();
  for (int kt = 0; kt < ntile; ++kt) {
    __syncthreads();
    *(u32x4*)(Ks + kkey0 * 104 + kch0 * 8) = rk0;
    if (tid < 256) *(u32x4*)(Ks + kkey1 * 104 + kch1 * 8) = rk1;
    *(u32x4*)(Vs + vkey * 72 + vc0) = rv;
    __syncthreads();
    if (kt + 1 < ntile) ATT_ADV(kt + 1);
    ATT_LOAD();
    f32x4 s[2][4];
#pragma unroll
    for (int t4 = 0; t4 < 4; ++t4) { s[0][t4] = (f32x4){0.f, 0.f, 0.f, 0.f}; s[1][t4] = (f32x4){0.f, 0.f, 0.f, 0.f};
#pragma unroll
      for (int ks = 0; ks < 3; ++ks) { const bf16x8 kf = *(const bf16x8*)(Ks + (16 * t4 + r16) * 104 + ks * 32 + g * 8);
        s[0][t4] = __builtin_amdgcn_mfma_f32_16x16x32_bf16(kf, qf[0][ks], s[0][t4], 0, 0, 0); s[1][t4] = __builtin_amdgcn_mfma_f32_16x16x32_bf16(kf, qf[1][ks], s[1][t4], 0, 0, 0); } }
    bf16x8 pf[2][2];
#pragma unroll
    for (int sb = 0; sb < 2; ++sb) {
      float mx = -1e30f;
#pragma unroll
      for (int t4 = 0; t4 < 4; ++t4)
#pragma unroll
        for (int r = 0; r < 4; ++r) mx = fmaxf(mx, s[sb][t4][r]);
      mx = fmaxf(mx, __shfl_xor(mx, 16)); mx = fmaxf(mx, __shfl_xor(mx, 32));
      const float m_new = fmaxf(m_run[sb], mx * cscale); const float alpha = __builtin_amdgcn_exp2f(m_run[sb] - m_new); m_run[sb] = m_new;
      float rs = 0.f;
#pragma unroll
      for (int t4 = 0; t4 < 4; ++t4)
#pragma unroll
        for (int r = 0; r < 4; ++r) { const float pv = __builtin_amdgcn_exp2f(s[sb][t4][r] * cscale - m_new); s[sb][t4][r] = pv; rs += pv; }
      rs += __shfl_xor(rs, 16); rs += __shfl_xor(rs, 32);
      l_run[sb] = l_run[sb] * alpha + rs;
#pragma unroll
      for (int i = 0; i < 4; ++i) o[sb][i] = o[sb][i] * alpha;
#pragma unroll
      for (int kk = 0; kk < 2; ++kk) { u32x4 pw; pw.x = pk2(s[sb][2 * kk][0], s[sb][2 * kk][1]); pw.y = pk2(s[sb][2 * kk][2], s[sb][2 * kk][3]); pw.z = pk2(s[sb][2 * kk + 1][0], s[sb][2 * kk + 1][1]); pw.w = pk2(s[sb][2 * kk + 1][2], s[sb][2 * kk + 1][3]);
        pf[sb][kk] = *(const bf16x8*)&pw; }
    }
#pragma unroll
    for (int kk = 0; kk < 2; ++kk)
#pragma unroll
      for (int vt = 0; vt < 4; ++vt) {
        const bf16_t* vp = Vs + (32 * kk + 4 * g + (r16 >> 2)) * 72 + 16 * vt + 4 * (r16 & 3); const bf16x8 vf = tr_pair(vp, vp + 16 * 72);
        o[0][vt] = __builtin_amdgcn_mfma_f32_16x16x32_bf16(vf, pf[0][kk], o[0][vt], 0, 0, 0); o[1][vt] = __builtin_amdgcn_mfma_f32_16x16x32_bf16(vf, pf[1][kk], o[1][vt], 0, 0, 0);
      }
  }
#undef ATT_LOAD
#undef ATT_ADV
#pragma unroll
  for (int sb = 0; sb < 2; ++sb) { const float inv = 1.f / l_run[sb]; const int qrow = row0 + wave * 32 + sb * 16 + r16;
#pragma unroll
    for (int vt = 0; vt < 4; ++vt) { u32x2 w; w.x = pk2(o[sb][vt][0] * inv, o[sb][vt][1] * inv); w.y = pk2(o[sb][vt][2] * inv, o[sb][vt][3] * inv); *(u32x2*)(ATT + (size_t)qrow * 512 + h * 64 + 16 * vt + 4 * g) = w; } }
}

__device__ void mlstm_item(const Params& p, int grp, int chain, int slice, int cb, int ce, char* lds) {
  const int tid = otid(), wave = tid >> 6, lane = tid & 63, r16 = lane & 15, g = lane >> 4;
  const int b = chain >> 3, dir = (chain >> 2) & 1, h = chain & 3;
  const int base = grp ? NCTX + b * 2048 : b * 256, S = grp ? 2048 : 256, nc = ce - cb;
  const int gidx00 = grp ? chain * 32 : 512 + chain * 4; const int gidx0 = gidx00 + cb;
  bf16_t* Qs = (bf16_t*)lds;
  bf16_t* Ks = Qs + 64 * 136;
  bf16_t* Kw = Ks + 64 * 136;
  bf16_t* VV = Kw + 64 * 136;
  bf16_t* Sp = VV + 64 * 136;
  bf16_t* Cb = Sp + 64 * 72;
  float* fl = (float*)(Cb + 128 * 136);
  float* s_gb = fl; float* s_den = fl + 256; float* s_qn = fl + 384; float* s_n = fl + 448; float* s_nsum = fl + 576;
  const bf16_t* Z = (const bf16_t*)(p.ws + WS_Z); const f32x4* GB = (const f32x4*)(p.ws + WS_GB); typedef float f32x2 __attribute__((ext_vector_type(2))); const f32x2* GL = (const f32x2*)(p.ws + WS_GL);
  bf16_t* Hout = (bf16_t*)(p.ws + (dir ? WS_HB : WS_HF));
  const int sidx = ((b * 2 + dir) * 4 + h);
  const int lrow = tid >> 4, lch = tid & 15;
  f32x4 accC[8]; float m_run = 0.f;
  if (grp) {
    const float* C0 = p.state_C + ((size_t)sidx * 256 + slice * 128) * 128;
#pragma unroll
    for (int i = 0; i < 8; ++i) accC[i] = *(const f32x4*)(C0 + (16 * wave + r16) * 128 + 16 * i + 4 * g);
    if (tid < 128) s_n[tid] = p.state_n[sidx * 128 + tid];
    m_run = p.state_m[sidx];
  } else {
#pragma unroll
    for (int i = 0; i < 8; ++i) accC[i] = (f32x4){0.f, 0.f, 0.f, 0.f};
    if (tid < 128) s_n[tid] = 0.f;
  }
  if (cb > 0) {
    bf16_t* KwB = (bf16_t*)lds; bf16_t* VVB = KwB + 2 * 64 * 136;
    const int nd = tid & 127, npart = tid >> 7;
    __syncthreads();
    float n_part = npart == 0 ? s_n[nd] : 0.f;
    u32x4 ska_[2], skb_[2], sva_[2], svb_[2]; float swa_[2], swb_[2]; f32x2 sgl_[2];
#define SC_TOK(c_, r_) (base + (dir ? S - 1 - ((c_) * 64 + (r_)) : (c_) * 64 + (r_)))
#define SC_LOAD(c_, P) do { const bf16_t* za_ = Z + (size_t)SC_TOK(c_, lrow) * N_INP; const bf16_t* zb_ = Z + (size_t)SC_TOK(c_, lrow + 32) * N_INP; \
    ska_[P] = *(const u32x4*)(za_ + OFF_MK + h * 128 + lch * 8); skb_[P] = *(const u32x4*)(zb_ + OFF_MK + h * 128 + lch * 8); \
    sva_[P] = *(const u32x4*)(za_ + OFF_MV + h * 256 + slice * 128 + lch * 8); svb_[P] = *(const u32x4*)(zb_ + OFF_MV + h * 256 + slice * 128 + lch * 8); \
    swa_[P] = ((const float*)(GB + (size_t)(gidx00 + (c_)) * 64 + lrow))[1]; swb_[P] = ((const float*)(GB + (size_t)(gidx00 + (c_)) * 64 + lrow + 32))[1]; sgl_[P] = GL[gidx00 + (c_)]; } while (0)
    SC_LOAD(0, 0); SC_LOAD(1, 1);
    for (int c2 = 0; c2 < cb; c2 += 2) {
#pragma unroll
    for (int par = 0; par < 2; ++par) {
      const int c = c2 + par;
      bf16_t* Kw2 = KwB + par * (64 * 136); bf16_t* VV2 = VVB + par * (64 * 136);
      const float b_last = sgl_[par][0], amax = sgl_[par][1];
      const float m_new = b_last + fmaxf(m_run, amax); const float decay = __expf(b_last + m_run - m_new); m_run = m_new;
      { const float wa = __expf(b_last + swa_[par] - m_new), wb = __expf(b_last + swb_[par] - m_new); u32x4 wa4, wb4;
#pragma unroll
        for (int jj = 0; jj < 4; ++jj) { wa4[jj] = pk2(wa * bflo(ska_[par][jj]), wa * bfhi(ska_[par][jj])); wb4[jj] = pk2(wb * bflo(skb_[par][jj]), wb * bfhi(skb_[par][jj])); }
        *(u32x4*)(Kw2 + lrow * 136 + lch * 8) = wa4; *(u32x4*)(Kw2 + (lrow + 32) * 136 + lch * 8) = wb4;
        *(u32x4*)(VV2 + lrow * 136 + lch * 8) = sva_[par]; *(u32x4*)(VV2 + (lrow + 32) * 136 + lch * 8) = svb_[par]; }
      __syncthreads();
      SC_LOAD((c + 2 < cb ? c + 2 : cb - 1), par);
      bf16x8 bv[2], ka[2][8], dm0, dm1;
      tr_frag4<0, 32 * 136 * 2, 0, 32 * 136 * 2, 4 * 136 * 2>(VV2 + (8 * g + (r16 >> 2)) * 136 + 16 * wave + 4 * (r16 & 3), bv[0], bv[1], dm0, dm1);
      const bf16_t* kp0 = Kw2 + (8 * g + (r16 >> 2)) * 136 + 4 * (r16 & 3);
      tr_frag4<0, 32, 64, 96, 4 * 136 * 2>(kp0, ka[0][0], ka[0][1], ka[0][2], ka[0][3]);
      tr_frag4<128, 160, 192, 224, 4 * 136 * 2>(kp0, ka[0][4], ka[0][5], ka[0][6], ka[0][7]);
      tr_frag4<32 * 136 * 2, 32 * 136 * 2 + 32, 32 * 136 * 2 + 64, 32 * 136 * 2 + 96, 4 * 136 * 2>(kp0, ka[1][0], ka[1][1], ka[1][2], ka[1][3]);
      tr_frag4<32 * 136 * 2 + 128, 32 * 136 * 2 + 160, 32 * 136 * 2 + 192, 32 * 136 * 2 + 224, 4 * 136 * 2>(kp0, ka[1][4], ka[1][5], ka[1][6], ka[1][7]);
#pragma unroll
      for (int i = 0; i < 8; ++i) { accC[i] = accC[i] * decay;
#pragma unroll
        for (int kk = 0; kk < 2; ++kk) accC[i] = __builtin_amdgcn_mfma_f32_16x16x32_bf16(ka[kk][i], bv[kk], accC[i], 0, 0, 0); }
      { float s = 0.f;
#pragma unroll
        for (int i = 0; i < 16; ++i) s += bf2f(Kw2[(npart * 16 + i) * 136 + nd]);
        n_part = decay * n_part + s; }
    }
    }
#undef SC_LOAD
#undef SC_TOK
    s_nsum[npart * 128 + nd] = n_part;
    __syncthreads();
    if (tid < 128) s_n[tid] = (s_nsum[tid] + s_nsum[128 + tid]) + (s_nsum[256 + tid] + s_nsum[384 + tid]);
    __syncthreads();
  }
#pragma unroll
  for (int i = 0; i < 8; ++i) { u32x2 w; w.x = pk2(accC[i][0], accC[i][1]); w.y = pk2(accC[i][2], accC[i][3]); *(u32x2*)(Cb + (16 * wave + r16) * 136 + 16 * i + 4 * g) = w; }
  u32x4 qa_[2], qb_[2], ka_[2], kb_[2], va_[2], vb_[2]; f32x4 ga_[2], gbb_[2]; f32x2 gl_[2];
#define ML_TOK(c_, r_) (base + (dir ? S - 1 - ((cb + (c_)) * 64 + (r_)) : (cb + (c_)) * 64 + (r_)))
#define ML_LOAD(c_, P) do { const bf16_t* za_ = Z + (size_t)ML_TOK(c_, lrow) * N_INP; const bf16_t* zb_ = Z + (size_t)ML_TOK(c_, lrow + 32) * N_INP; \
    qa_[P] = *(const u32x4*)(za_ + OFF_MQ + h * 128 + lch * 8); qb_[P] = *(const u32x4*)(zb_ + OFF_MQ + h * 128 + lch * 8); \
    ka_[P] = *(const u32x4*)(za_ + OFF_MK + h * 128 + lch * 8); kb_[P] = *(const u32x4*)(zb_ + OFF_MK + h * 128 + lch * 8); \
    va_[P] = *(const u32x4*)(za_ + OFF_MV + h * 256 + slice * 128 + lch * 8); vb_[P] = *(const u32x4*)(zb_ + OFF_MV + h * 256 + slice * 128 + lch * 8); \
    ga_[P] = GB[(size_t)(gidx0 + (c_)) * 64 + lrow]; gbb_[P] = GB[(size_t)(gidx0 + (c_)) * 64 + lrow + 32]; gl_[P] = GL[gidx0 + (c_)]; } while (0)
  ML_LOAD(0, 0); ML_LOAD(1, 1);
  for (int c2 = 0; c2 < nc; c2 += 2) {
#pragma unroll
  for (int par = 0; par < 2; ++par) {
    const int c = c2 + par;
    const float b_last = gl_[par][0], amax = gl_[par][1];
    const float m_old = m_run; const float m_new = b_last + fmaxf(m_old, amax); const float decay = __expf(b_last + m_old - m_new); m_run = m_new;
    {
      const float wa = __expf(b_last + ga_[par][1] - m_new), wb = __expf(b_last + gbb_[par][1] - m_new);
      if (lch == 0) { *(f32x4*)(s_gb + lrow * 4) = ga_[par]; *(f32x4*)(s_gb + (lrow + 32) * 4) = gbb_[par]; }
      *(u32x4*)(Qs + lrow * 136 + lch * 8) = qa_[par]; *(u32x4*)(Qs + (lrow + 32) * 136 + lch * 8) = qb_[par];
      *(u32x4*)(Ks + lrow * 136 + lch * 8) = ka_[par]; *(u32x4*)(Ks + (lrow + 32) * 136 + lch * 8) = kb_[par];
      u32x4 wa4, wb4;
#pragma unroll
      for (int jj = 0; jj < 4; ++jj) { wa4[jj] = pk2(wa * bflo(ka_[par][jj]), wa * bfhi(ka_[par][jj])); wb4[jj] = pk2(wb * bflo(kb_[par][jj]), wb * bfhi(kb_[par][jj])); }
      *(u32x4*)(Kw + lrow * 136 + lch * 8) = wa4; *(u32x4*)(Kw + (lrow + 32) * 136 + lch * 8) = wb4;
      *(u32x4*)(VV + lrow * 136 + lch * 8) = va_[par]; *(u32x4*)(VV + (lrow + 32) * 136 + lch * 8) = vb_[par];
    }
    __syncthreads();
    ML_LOAD((c + 2 < nc ? c + 2 : nc - 1), par);
    {
      const int j = tid >> 3, part = tid & 7; float s = 0.f;
#pragma unroll
      for (int i = 0; i < 2; ++i) { const u32x4 qq = *(const u32x4*)(Qs + j * 136 + part * 16 + i * 8); const f32x4 n0 = *(const f32x4*)(s_n + part * 16 + i * 8), n1 = *(const f32x4*)(s_n + part * 16 + i * 8 + 4);
        s += bflo(qq[0]) * n0[0] + bfhi(qq[0]) * n0[1] + bflo(qq[1]) * n0[2] + bfhi(qq[1]) * n0[3] + bflo(qq[2]) * n1[0] + bfhi(qq[2]) * n1[1] + bflo(qq[3]) * n1[2] + bfhi(qq[3]) * n1[3]; }
      s += __shfl_xor(s, 1); s += __shfl_xor(s, 2); s += __shfl_xor(s, 4);
      if (part == 0) s_qn[j] = s;
    }
    const int jt = wave & 3; const int j = 16 * jt + r16;
    const float bj = s_gb[j * 4], mmj = fmaxf(m_old, s_gb[j * 4 + 2]); const float mr = bj + mmj;
    {
      float psum = 0.f;
#pragma unroll
      for (int u = 0; u < 2; ++u) {
        const int st = (wave >> 2) + 2 * u; f32x4 acc = {0.f, 0.f, 0.f, 0.f};
#pragma unroll
        for (int ks = 0; ks < 4; ++ks) { const bf16x8 a = *(const bf16x8*)(Ks + (16 * st + r16) * 136 + ks * 32 + g * 8), bq = *(const bf16x8*)(Qs + j * 136 + ks * 32 + g * 8);
          acc = __builtin_amdgcn_mfma_f32_16x16x32_bf16(a, bq, acc, 0, 0, 0); }
        float sv[4]; float ps = 0.f;
#pragma unroll
        for (int r = 0; r < 4; ++r) { const int si = 16 * st + 4 * g + r; const float ev = __expf(fminf(bj + s_gb[si * 4 + 1] - mr, 0.f)); const float dv = (si <= j) ? ev : 0.f; sv[r] = acc[r] * dv; ps += sv[r]; }
        u32x2 w; w.x = pk2(sv[0], sv[1]); w.y = pk2(sv[2], sv[3]); *(u32x2*)(Sp + j * 72 + 16 * st + 4 * g) = w;
        ps += __shfl_xor(ps, 16); ps += __shfl_xor(ps, 32);
        psum += ps;
      }
      if (g == 0) s_den[(wave >> 2) * 64 + j] = psum;
    }
    __syncthreads();
    {
      const float wi = __expf(m_old - mmj); const float den = (s_den[j] + s_den[64 + j]) + wi * s_qn[j]; const float inv = 1.f / fmaxf(fabsf(den), __expf(-mr));
      const int tkj = ML_TOK(c, j);
      bf16x8 va[2][4];
      const bf16_t* vp0 = VV + (8 * g + (r16 >> 2)) * 136 + 64 * (wave >> 2) + 4 * (r16 & 3);
      tr_frag4<0, 32, 64, 96, 4 * 136 * 2>(vp0, va[0][0], va[0][1], va[0][2], va[0][3]);
      tr_frag4<32 * 136 * 2, 32 * 136 * 2 + 32, 32 * 136 * 2 + 64, 32 * 136 * 2 + 96, 4 * 136 * 2>(vp0, va[1][0], va[1][1], va[1][2], va[1][3]);
      bf16x8 bs[2], bq[4];
#pragma unroll
      for (int kk = 0; kk < 2; ++kk) bs[kk] = *(const bf16x8*)(Sp + j * 72 + 32 * kk + 8 * g);
#pragma unroll
      for (int kk = 0; kk < 4; ++kk) bq[kk] = *(const bf16x8*)(Qs + j * 136 + 32 * kk + 8 * g);
#pragma unroll
      for (int u = 0; u < 4; ++u) {
        const int vt2 = 4 * (wave >> 2) + u; f32x4 intra = {0.f, 0.f, 0.f, 0.f}, inter = {0.f, 0.f, 0.f, 0.f};
#pragma unroll
        for (int kk = 0; kk < 2; ++kk) intra = __builtin_amdgcn_mfma_f32_16x16x32_bf16(va[kk][u], bs[kk], intra, 0, 0, 0);
#pragma unroll
        for (int kk = 0; kk < 4; ++kk) { const bf16x8 a = *(const bf16x8*)(Cb + (16 * vt2 + r16) * 136 + 32 * kk + 8 * g); inter = __builtin_amdgcn_mfma_f32_16x16x32_bf16(a, bq[kk], inter, 0, 0, 0); }
        u32x2 w; w.x = pk2((intra[0] + wi * inter[0]) * inv, (intra[1] + wi * inter[1]) * inv); w.y = pk2((intra[2] + wi * inter[2]) * inv, (intra[3] + wi * inter[3]) * inv);
        *(u32x2*)(Hout + (size_t)tkj * 1024 + h * 256 + slice * 128 + 16 * vt2 + 4 * g) = w;
      }
    }
    {
      bf16x8 bv[2], ka[2][8], dm0, dm1;
      tr_frag4<0, 32 * 136 * 2, 0, 32 * 136 * 2, 4 * 136 * 2>(VV + (8 * g + (r16 >> 2)) * 136 + 16 * wave + 4 * (r16 & 3), bv[0], bv[1], dm0, dm1);
      const bf16_t* kp0 = Kw + (8 * g + (r16 >> 2)) * 136 + 4 * (r16 & 3);
      tr_frag4<0, 32, 64, 96, 4 * 136 * 2>(kp0, ka[0][0], ka[0][1], ka[0][2], ka[0][3]);
      tr_frag4<128, 160, 192, 224, 4 * 136 * 2>(kp0, ka[0][4], ka[0][5], ka[0][6], ka[0][7]);
      tr_frag4<32 * 136 * 2, 32 * 136 * 2 + 32, 32 * 136 * 2 + 64, 32 * 136 * 2 + 96, 4 * 136 * 2>(kp0, ka[1][0], ka[1][1], ka[1][2], ka[1][3]);
      tr_frag4<32 * 136 * 2 + 128, 32 * 136 * 2 + 160, 32 * 136 * 2 + 192, 32 * 136 * 2 + 224, 4 * 136 * 2>(kp0, ka[1][4], ka[1][5], ka[1][6], ka[1][7]);
#pragma unroll
      for (int i = 0; i < 8; ++i) {
        accC[i] = accC[i] * decay;
#pragma unroll
        for (int kk = 0; kk < 2; ++kk) accC[i] = __builtin_amdgcn_mfma_f32_16x16x32_bf16(ka[kk][i], bv[kk], accC[i], 0, 0, 0);
      }
      { const int d = tid & 127, part = tid >> 7; float s = 0.f;
#pragma unroll
        for (int i = 0; i < 16; ++i) s += bf2f(Kw[(part * 16 + i) * 136 + d]);
        s_nsum[part * 128 + d] = s; }
    }
    __syncthreads();
#pragma unroll
    for (int i = 0; i < 8; ++i) { u32x2 w; w.x = pk2(accC[i][0], accC[i][1]); w.y = pk2(accC[i][2], accC[i][3]); *(u32x2*)(Cb + (16 * wave + r16) * 136 + 16 * i + 4 * g) = w; }
    if (tid < 128) s_n[tid] = decay * s_n[tid] + ((s_nsum[tid] + s_nsum[128 + tid]) + (s_nsum[256 + tid] + s_nsum[384 + tid]));
  }
  }
#undef ML_LOAD
#undef ML_TOK
  if (!grp) {
    float* Co = p.out + OUT_C + ((size_t)sidx * 256 + slice * 128) * 128;
#pragma unroll
    for (int i = 0; i < 8; ++i) *(f32x4*)(Co + (16 * wave + r16) * 128 + 16 * i + 4 * g) = accC[i];
    if (slice == 0) { if (tid < 128) p.out[OUT_N + sidx * 128 + tid] = s_n[tid]; if (tid == 0) p.out[OUT_M + sidx] = m_run; }
  }
}

__device__ void phase_mixer(const Params& p, char* lds) {
  unsigned* ctrl = (unsigned*)(p.ws + WS_CTRL);
  int* s_item = (int*)(lds + 128 * 1024 + 64);
  constexpr int N_ML_LAT = 128, N_AT_LAT = 128, N_ML_CTX = 256, N_AT_CTX = 128, TOTAL = N_ML_LAT + N_AT_LAT + N_ML_CTX + N_AT_CTX;
  if (__builtin_amdgcn_readfirstlane(otid()) >= 256) __builtin_amdgcn_s_setprio(1);
  for (;;) {
    __syncthreads();
    if (otid() == 0) *s_item = (int)atomicAdd(ctrl, 1u);
    __syncthreads();
    int it = *s_item;
    if (it >= TOTAL) break;
    int kind, a0 = 0, a1 = 0, a2 = 0, a3 = 0, a4 = 0;
    if (it < N_ML_LAT) { kind = 2; a0 = 1; a1 = (it & 31) >> 1; a2 = it & 1; a3 = 8 * (3 - (it >> 5)); a4 = a3 + 8; }
    else if ((it -= N_ML_LAT) < N_AT_LAT) { kind = 1; a0 = 1; a1 = it >> 6; a2 = (it >> 3) & 7; a3 = it & 7; }
    else if ((it -= N_AT_LAT) < N_ML_CTX) { kind = 2; a0 = 0; a1 = it >> 1; a2 = it & 1; a3 = 0; a4 = 4; }
    else { it -= N_ML_CTX; kind = 1; a0 = 0; a1 = it >> 3; a2 = it & 7; a3 = 0; }
    if (kind == 1) attn_item(p, a0, a1, a2, a3, lds);
    else mlstm_item(p, a0, a1, a2, a3, a4, lds);
  }
  __builtin_amdgcn_s_setprio(0);
}

#define XB_TMO      128
#define XB_XCNT(j)  (256  + 64 * (j))
#define XB_XSUB(j)  (1280 + 64 * (j))
#define XB_XGEN(j)  (2304 + 64 * (j))
#define XB_TOP      3328
#define XB_TOPGEN   3392
#define XCD_BAR_WORDS 3456
#define XB_SPIN_CAP (1u << 18)
#define LAS3 __attribute__((address_space(3)))
__device__ __forceinline__ unsigned xb_ld(unsigned* p)              { return __hip_atomic_load(p, __ATOMIC_RELAXED, __HIP_MEMORY_SCOPE_AGENT); }
__device__ __forceinline__ unsigned xb_add(unsigned* p, unsigned v) { return __hip_atomic_fetch_add(p, v, __ATOMIC_RELAXED, __HIP_MEMORY_SCOPE_AGENT); }
__device__ __forceinline__ unsigned xb_xcc_id() { return (unsigned)__builtin_amdgcn_s_getreg((3 << 11) | 20) & 0xFu; }
#define XB_SPIN(cond, bar) do { unsigned _sp = 0; while (cond) { __builtin_amdgcn_s_sleep(16); \
    if ((++_sp & 255u) == 0u) { if (xb_ld(&(bar)[XB_TMO])) break; if (_sp > XB_SPIN_CAP) { atomicAdd(&(bar)[XB_TMO], 1u); break; } } } } while (0)
struct XcdBarrier { unsigned* bar; unsigned x; volatile LAS3 unsigned* st; };
__device__ __forceinline__ XcdBarrier xcd_barrier_post(unsigned* bar, volatile LAS3 unsigned* st) {
  XcdBarrier b; b.bar = bar; b.x = xb_xcc_id(); b.st = st;
  if (threadIdx.x == 0) (void)xb_add(&bar[XB_XCNT(b.x)], 1u);
  return b;
}
__device__ __forceinline__ void xcd_barrier_complete(unsigned* bar, unsigned x, unsigned& nloc, unsigned& nx) {
  const unsigned G = gridDim.x * gridDim.y * gridDim.z;
  unsigned sum, cnt, mine, sp = 0u;
  for (;;) {
    sum = 0u; cnt = 0u; mine = 0u;
#pragma unroll
    for (unsigned j = 0; j < 16; ++j) { const unsigned c = xb_ld(&bar[XB_XCNT(j)]); sum += c; cnt += (c > 0u) ? 1u : 0u; mine = (j == x) ? c : mine; }
    if (sum == G) break;
    __builtin_amdgcn_s_sleep(1);
    if ((++sp & 255u) == 0u) { if (xb_ld(&bar[XB_TMO])) break; if (sp > XB_SPIN_CAP) { atomicAdd(&bar[XB_TMO], 1u); break; } }
  }
  nloc = mine > 0u ? mine : 1u; nx = cnt > 0u ? cnt : 1u;
}
__device__ __forceinline__ void xcd_barrier(const XcdBarrier& b) {
  asm volatile("s_waitcnt vmcnt(0)" ::: "memory");
  __syncthreads();
  if (threadIdx.x == 0) {
    unsigned* bar = b.bar;
    __builtin_amdgcn_s_waitcnt(0);
    unsigned nloc = b.st[0], nx = b.st[1];
    if (nloc == 0u) { xcd_barrier_complete(bar, b.x, nloc, nx); b.st[0] = nloc; b.st[1] = nx; }
    const unsigned old = xb_add(&bar[XB_XSUB(b.x)], 1u);
    const unsigned gen = old / nloc;
    if (old + 1u == (gen + 1u) * nloc) {
      __builtin_amdgcn_fence(__ATOMIC_RELEASE, "agent");
      asm volatile("s_waitcnt vmcnt(0)" ::: "memory");
      const unsigned og = xb_add(&bar[XB_TOP], 1u);
      const unsigned tg = og / nx;
      if (og + 1u == (tg + 1u) * nx) xb_add(&bar[XB_TOPGEN], 1u);
      else XB_SPIN(xb_ld(&bar[XB_TOPGEN]) == tg, bar);
      __builtin_amdgcn_fence(__ATOMIC_ACQUIRE, "agent");
      xb_add(&bar[XB_XGEN(b.x)], 1u);
      asm volatile("s_waitcnt vmcnt(0)" ::: "memory");
    } else {
      XB_SPIN(xb_ld(&bar[XB_XGEN(b.x)]) == gen, bar);
      __builtin_amdgcn_fence(__ATOMIC_ACQUIRE, "agent");
      asm volatile("s_waitcnt vmcnt(0)" ::: "memory");
    }
  }
  __syncthreads();
}

constexpr int LDS_BYTES = 128 * 1024 + 256;
struct EpiAll { int mode; char* ws; const float* b_gates;
  template <class F> __device__ __forceinline__ void run(const F& f, const f32x4 (&acc)[2][2][4][2], const pg8::Unit& u, int wr, int wc, int fr, int fq) const {
#pragma unroll
    for (int ai = 0; ai < 2; ++ai)
#pragma unroll
      for (int m = 0; m < 4; ++m) { const int row = u.pm * 256 + ai * 128 + wr * 64 + m * 16 + fr;
#pragma unroll
        for (int bj = 0; bj < 2; ++bj)
        { f(row, u.pn * 256 + bj * 128 + wc * 32 + 8 * fq, acc[ai][bj][m][0], acc[ai][bj][m][1], u.kpart); asm volatile("" ::: "memory"); }
        asm volatile("" ::: "memory"); }
  }
  __device__ __forceinline__ void operator()(const f32x4 (&acc)[2][2][4][2], const pg8::Unit& u, int wr, int wc, int fr, int fq) const {
    bf16_t* Z = (bf16_t*)(ws + WS_Z);
    switch (mode) {
      case 0: { EpiZ e{Z, (float*)(ws + WS_GATES), b_gates}; run(e, acc, u, wr, wc, fr, fq); } break;
      case 1: { EpiQ e{(bf16_t*)(ws + WS_Q), (const float*)(ws + WS_ROPE)}; run(e, acc, u, wr, wc, fr, fq); } break;
      case 2: { EpiBf e{(bf16_t*)(ws + WS_KV), 1024}; run(e, acc, u, wr, wc, fr, fq); } break;
      case 3: { EpiT1 e{(bf16_t*)(ws + WS_T1), Z}; run(e, acc, u, wr, wc, fr, fq); } break;
      case 4: { EpiMG e{(const bf16_t*)(ws + WS_T1), Z, (bf16_t*)(ws + WS_B)}; run(e, acc, u, wr, wc, fr, fq); } break;
      case 5: { EpiPart e{(bf16_t*)(ws + WS_PA1), (bf16_t*)(ws + WS_PB1)}; run(e, acc, u, wr, wc, fr, fq); } break;
      case 6: { EpiAct e{(bf16_t*)(ws + WS_ACT)};
#pragma unroll
        for (int ai = 0; ai < 2; ++ai)
#pragma unroll
          for (int m = 0; m < 4; ++m) { e(u.pm * 256 + ai * 128 + wr * 64 + m * 16 + fr, u.pn * 128 + wc * 32 + 8 * fq, acc[ai][0][m][0], acc[ai][0][m][1], acc[ai][1][m][0], acc[ai][1][m][1]); asm volatile("" ::: "memory"); }
      } break;
      default: { EpiPart e{(bf16_t*)(ws + WS_PA2), (bf16_t*)(ws + WS_PB2)}; run(e, acc, u, wr, wc, fr, fq); } break;
    }
  } };
struct GemmDesc { size_t A, Bt; int lda, ldb, M, N, K, parts, c0, mode; };

__global__ void __launch_bounds__(512, 2) fwd_megakernel(Params p) {
  cg::grid_group grid = cg::this_grid();
  extern __shared__ __attribute__((aligned(16))) unsigned char lds_dyn[];
  PG8_LAS unsigned char* l3 = (PG8_LAS unsigned char*)lds_dyn; char* lds = (char*)lds_dyn;
  char* ws = p.ws;
  volatile LAS3 unsigned* xst = (volatile LAS3 unsigned*)(l3 + 128 * 1024);
  if (threadIdx.x < 4) xst[threadIdx.x] = 0u;
  __syncthreads();
  XcdBarrier xbar = xcd_barrier_post((unsigned*)(ws + WS_BAR), xst);
  if (p.out == nullptr) grid.sync();
#pragma unroll 1
  for (int ph = 0; ph < 15; ++ph) {
    GemmDesc d; d.mode = -1; d.A = 0; d.Bt = 0; d.lda = d.ldb = d.M = d.N = d.K = d.parts = d.c0 = 0;
    switch (ph) {
      case 0: phase_prologue(p, lds); break;
      case 1: phase_norm_mod(p, nullptr, nullptr, 0, (bf16_t*)nullptr, p.g_norm_mix, 0, 1, (bf16_t*)(ws + WS_B)); break;
      case 2: d = GemmDesc{WS_B, WS_WIN, 1024, 1024, T, N_INP, 1024, 1, 0, 0}; break;
      case 3: phase_prep(p); break;
      case 4: d = GemmDesc{WS_QN, WS_WUQ, 384, 384, T, 768, 384, 1, 0, 1}; break;
      case 5: d = GemmDesc{WS_CKV, WS_WUKV, 256, 256, TKV, 1024, 256, 1, 160, 2}; break;
      case 6: phase_mixer(p, lds); break;
      case 7: phase_hm(p); break;
      case 8: d = GemmDesc{WS_ATT, WS_WOMLA, 512, 512, T, 1024, 512, 1, 0, 3}; break;
      case 9: d = GemmDesc{WS_HM, WS_WOMLSTM, 1024, 1024, T, 1024, 1024, 1, 0, 4}; break;
      case 10: d = GemmDesc{WS_B, WS_WOUT, 1024, 1024, T, 1024, 512, 2, 0, 5}; break;
      case 11: phase_norm_mod(p, (const bf16_t*)(ws + WS_PA1), (const bf16_t*)(ws + WS_PB1), 2, (bf16_t*)(ws + WS_X1), p.g_norm_ffn, 3, 4, (bf16_t*)(ws + WS_B)); break;
      case 12: d = GemmDesc{WS_B, WS_WFIN, 1024, 1024, T, 5632, 1024, 1, 0, 6}; break;
      case 13: d = GemmDesc{WS_ACT, WS_WFOUT, FFN, FFN, T, 1024, FFN / 2, 2, 0, 7}; break;
      default: phase_final_norm(p); break;
    }
    if (d.mode >= 0) {
      pg8::Gemm g{(const bf16_t*)(ws + d.A), (const bf16_t*)(ws + d.Bt), d.lda, d.ldb, d.K}; pg8::Order S; S.init(d.M, d.N, (int)gridDim.x, (int)((blockIdx.x + d.c0) % gridDim.x), d.parts);
      EpiAll E{d.mode, ws, p.b_gates}; pg8::gemm_phase<EpiAll>(l3, g, S, E);
    }
    if (ph != 4 && ph != 8 && ph != 14) xcd_barrier(xbar);
  }
}

extern "C" void kernel_launch(void* const* d_in, const int* in_sizes, int n_in, void* d_out, int out_size, void* d_ws, size_t ws_size, hipStream_t stream) {
  static int grid_blocks = 0;
  if (!grid_blocks) {
    int dev = 0, cus = 0, per_cu = 0;
    (void)hipGetDevice(&dev);
    (void)hipDeviceGetAttribute(&cus, hipDeviceAttributeMultiprocessorCount, dev);
    (void)hipFuncSetAttribute((const void*)fwd_megakernel, hipFuncAttributeMaxDynamicSharedMemorySize, LDS_BYTES);
    (void)hipOccupancyMaxActiveBlocksPerMultiprocessor(&per_cu, fwd_megakernel, 512, LDS_BYTES);
    if (per_cu > 1) per_cu = 1;
    if (per_cu < 1) per_cu = 1;
    grid_blocks = cus * per_cu;
  }
  if (ws_size < WS_END) fprintf(stderr, "workspace too small: %zu < %zu\n", ws_size, (size_t)WS_END);
  Params p{};
  const float** pp = (const float**)&p;
  for (int i = 0; i < 26; ++i) pp[i] = (const float*)d_in[i];
  p.out = (float*)d_out; p.ws = (char*)d_ws;
  (void)hipMemsetAsync(d_ws, 0, WS_ROPE, stream);
  void* args[] = {&p};
  hipError_t e = hipLaunchCooperativeKernel((void*)fwd_megakernel, dim3(grid_blocks), dim3(512), args, LDS_BYTES, stream);
  if (e != hipSuccess) fprintf(stderr, "cooperative launch failed: %s (grid %d)\n", hipGetErrorString(e), grid_blocks);
}
```

```cpp
#include <hip/hip_runtime.h>
#include <hip/hip_cooperative_groups.h>
#include <cstdio>
#include <cstdint>
namespace cg = cooperative_groups;

typedef unsigned short bf16_t;
typedef short bf16x8 __attribute__((ext_vector_type(8)));
typedef float f32x4 __attribute__((ext_vector_type(4)));
typedef unsigned u32x4 __attribute__((ext_vector_type(4)));
typedef unsigned u32x2 __attribute__((ext_vector_type(2)));

constexpr int T = 8192, NCTX = 4096;
constexpr int N_IN = 5808, N_INP = 5888;
constexpr int OFF_ZQ = 0, OFF_ZKV = 384, OFF_ZKPE = 640, OFF_MQ = 672, OFF_MK = 1184, OFF_MV = 1696, OFF_GATE = 2720, OFF_MO = 2736, OFF_BR = 3760;
constexpr int FFN = 2816, TKV = 8704;
constexpr float EPS = 1e-6f;

constexpr size_t OUT_Y = 0;
constexpr size_t OUT_CKV = (size_t)T * 1024;
constexpr size_t OUT_KROPE = OUT_CKV + (size_t)16 * 256 * 256;
constexpr size_t OUT_C = OUT_KROPE + (size_t)16 * 256 * 32;
constexpr size_t OUT_N = OUT_C + (size_t)16 * 2 * 4 * 256 * 128;
constexpr size_t OUT_M = OUT_N + (size_t)16 * 2 * 4 * 128;

constexpr size_t WS_CTRL = 0;
constexpr size_t WS_BAR = 256;
constexpr size_t WS_ROPE = 256 + 16384;
constexpr size_t WS_MOD = WS_ROPE + 4096;
constexpr size_t WS_WIN = WS_MOD + 3 * 6144 * 4;
constexpr size_t WS_WUQ = WS_WIN + (size_t)N_INP * 1024 * 2;
constexpr size_t WS_WUKV = WS_WUQ + (size_t)768 * 384 * 2;
constexpr size_t WS_WOMLA = WS_WUKV + (size_t)1024 * 256 * 2;
constexpr size_t WS_WOMLSTM = WS_WOMLA + (size_t)1024 * 512 * 2;
constexpr size_t WS_WOUT = WS_WOMLSTM + (size_t)1024 * 1024 * 2;
constexpr size_t WS_WFIN = WS_WOUT + (size_t)1024 * 1024 * 2;
constexpr size_t WS_WFOUT = WS_WFIN + (size_t)5632 * 1024 * 2;
constexpr size_t WS_GATES = WS_WFOUT + (size_t)1024 * 2816 * 2;
constexpr size_t WS_GB = WS_GATES + (size_t)T * 16 * 4;
constexpr size_t WS_GL = WS_GB + (size_t)1024 * 64 * 16;
constexpr size_t WS_A = WS_GL + (size_t)1024 * 8;
constexpr size_t WS_Z = WS_A;
constexpr size_t WS_PA1 = WS_A;
constexpr size_t WS_PB1 = WS_A + ((size_t)1 << 25);
constexpr size_t WS_ACT = WS_A;
constexpr size_t WS_PA2 = WS_A + ((size_t)48 << 20);
constexpr size_t WS_B = WS_A + (size_t)T * N_INP * 2;
constexpr size_t WS_C = WS_B + (size_t)T * 1024 * 2;
constexpr size_t WS_QN = WS_C;
constexpr size_t WS_CKV = WS_QN + (size_t)T * 384 * 2;
constexpr size_t WS_KPE = WS_CKV + (size_t)TKV * 256 * 2;
constexpr size_t WS_Q = WS_KPE + (size_t)TKV * 32 * 2;
constexpr size_t WS_KV = WS_Q + (size_t)T * 768 * 2;
constexpr size_t WS_ATT = WS_KV + (size_t)TKV * 1024 * 2;
constexpr size_t WS_X1 = WS_C;
constexpr size_t WS_D = WS_ATT + (size_t)T * 512 * 2;
constexpr size_t WS_HF = WS_D;
constexpr size_t WS_HB = WS_HF + (size_t)T * 1024 * 2;
constexpr size_t WS_T1 = WS_HF;
constexpr size_t WS_PB2 = WS_D;
constexpr size_t WS_HM = WS_HB + (size_t)T * 1024 * 2;
constexpr size_t WS_END = WS_HM + (size_t)T * 1024 * 2;
static_assert((size_t)T * FFN * 2 <= ((size_t)48 << 20), "ACT vs PA2 overlap");
static_assert(WS_PA2 + ((size_t)1 << 25) <= WS_B, "PA2 fits region A");

struct Params {
  const float* x_prompt; const float* x_sample; const float* cache_ckv; const float* cache_krope;
  const float* state_C; const float* state_n; const float* state_m; const float* c; const float* c_ctx;
  const float* w_mod; const float* b_mod; const float* g_norm_mix; const float* w_in; const float* b_gates;
  const float* g_q_norm; const float* w_uq; const float* g_kv_norm; const float* w_ukv; const float* g_mlstm_norm;
  const float* w_o_mla; const float* w_o_mlstm; const float* w_out; const float* g_norm_ffn; const float* w_ffn_in;
  const float* w_ffn_out; const float* g_final;
  float* out; char* ws;
};

__device__ __forceinline__ bf16_t f2bf(float f) { unsigned u = __float_as_uint(f); u += 0x7fffu + ((u >> 16) & 1u); return (bf16_t)(u >> 16); }
__device__ __forceinline__ float bf2f(bf16_t b) { return __uint_as_float(((unsigned)b) << 16); }
__device__ __forceinline__ unsigned pk2(float lo, float hi) { unsigned r; asm("v_cvt_pk_bf16_f32 %0, %1, %2" : "=v"(r) : "v"(lo), "v"(hi)); return r; }
__device__ __forceinline__ float bflo(unsigned w) { return __uint_as_float(w << 16); }
__device__ __forceinline__ float bfhi(unsigned w) { return __uint_as_float(w & 0xffff0000u); }
__device__ __forceinline__ float sigmoidf_(float x) { return __builtin_amdgcn_rcpf(1.f + __expf(-x)); }
__device__ __forceinline__ const float* xrow(const Params& p, int tok) { return tok < NCTX ? p.x_prompt + (size_t)tok * 1024 : p.x_sample + (size_t)(tok - NCTX) * 1024; }
__device__ __forceinline__ int cond_of(int tok) { return tok < NCTX ? 0 : 1 + ((tok - NCTX) >> 11); }
__device__ __forceinline__ int otid() { int t = threadIdx.x; asm volatile("" : "+v"(t)); return t; }
typedef short s16x4 __attribute__((ext_vector_type(4)));
__device__ __forceinline__ bf16x8 tr_pair(const bf16_t* p0, const bf16_t* p1) {
  const unsigned a0 = (unsigned)(size_t)(__attribute__((address_space(3))) const bf16_t*)p0, a1 = (unsigned)(size_t)(__attribute__((address_space(3))) const bf16_t*)p1;
  s16x4 lo, hi;
  asm volatile("ds_read_b64_tr_b16 %0, %2\n\tds_read_b64_tr_b16 %1, %3\n\ts_waitcnt lgkmcnt(0)" : "=&v"(lo), "=&v"(hi) : "v"(a0), "v"(a1) : "memory");
  return (bf16x8){lo[0], lo[1], lo[2], lo[3], hi[0], hi[1], hi[2], hi[3]};
}
template <int O0, int O1, int O2, int O3, int STEP>
__device__ __forceinline__ void tr_frag4(const bf16_t* p, bf16x8& f0, bf16x8& f1, bf16x8& f2, bf16x8& f3) {
  const unsigned a = (unsigned)(size_t)(__attribute__((address_space(3))) const bf16_t*)p;
  s16x4 l0, h0, l1, h1, l2, h2, l3, h3;
  asm volatile("ds_read_b64_tr_b16 %0, %8 offset:%9\n\tds_read_b64_tr_b16 %1, %8 offset:%10\n\tds_read_b64_tr_b16 %2, %8 offset:%11\n\tds_read_b64_tr_b16 %3, %8 offset:%12\n\t"
               "ds_read_b64_tr_b16 %4, %8 offset:%13\n\tds_read_b64_tr_b16 %5, %8 offset:%14\n\tds_read_b64_tr_b16 %6, %8 offset:%15\n\tds_read_b64_tr_b16 %7, %8 offset:%16\n\ts_waitcnt lgkmcnt(0)"
               : "=&v"(l0), "=&v"(h0), "=&v"(l1), "=&v"(h1), "=&v"(l2), "=&v"(h2), "=&v"(l3), "=&v"(h3)
               : "v"(a), "i"(O0), "i"(O0 + STEP), "i"(O1), "i"(O1 + STEP), "i"(O2), "i"(O2 + STEP), "i"(O3), "i"(O3 + STEP) : "memory");
  f0 = (bf16x8){l0[0], l0[1], l0[2], l0[3], h0[0], h0[1], h0[2], h0[3]}; f1 = (bf16x8){l1[0], l1[1], l1[2], l1[3], h1[0], h1[1], h1[2], h1[3]};
  f2 = (bf16x8){l2[0], l2[1], l2[2], l2[3], h2[0], h2[1], h2[2], h2[3]}; f3 = (bf16x8){l3[0], l3[1], l3[2], l3[3], h3[0], h3[1], h3[2], h3[3]};
}
__device__ __forceinline__ float wave_sum(float v) {
#pragma unroll
  for (int o = 32; o >= 1; o >>= 1) v += __shfl_xor(v, o);
  return v;
}

template <class Epi>
__device__ __forceinline__ void gemm_tile(const bf16_t* __restrict__ A, int lda, const bf16_t* __restrict__ Bt, int ldb, int K, int row0, int col0, char* lds, const Epi& epi) {
  bf16_t* As = (bf16_t*)lds; bf16_t* Bs = As + 128 * 72;
  const int tid = otid(), wave = tid >> 6, lane = tid & 63, r16 = lane & 15, g = lane >> 4;
  const int wm = wave >> 2, wn = wave & 3;
  f32x4 acc[4][2];
#pragma unroll
  for (int m = 0; m < 4; ++m)
#pragma unroll
    for (int n = 0; n < 2; ++n) acc[m][n] = (f32x4){0.f, 0.f, 0.f, 0.f};
  const int lr0 = tid >> 3, lk = (tid & 7) * 8;
  const bf16_t* ag0 = A + (size_t)(row0 + lr0) * lda + lk; const bf16_t* ag1 = ag0 + (size_t)64 * lda;
  const bf16_t* bg0 = Bt + (size_t)(col0 + lr0) * ldb + lk; const bf16_t* bg1 = bg0 + (size_t)64 * ldb;
  u32x4 ra0 = *(const u32x4*)ag0, ra1 = *(const u32x4*)ag1, rb0 = *(const u32x4*)bg0, rb1 = *(const u32x4*)bg1;
  const int nk = K >> 6;
  for (int kt = 0; kt < nk; ++kt) {
    __syncthreads();
    *(u32x4*)(As + lr0 * 72 + lk) = ra0; *(u32x4*)(As + (lr0 + 64) * 72 + lk) = ra1;
    *(u32x4*)(Bs + lr0 * 72 + lk) = rb0; *(u32x4*)(Bs + (lr0 + 64) * 72 + lk) = rb1;
    __syncthreads();
    if (kt + 1 < nk) { const int ko = (kt + 1) * 64; ra0 = *(const u32x4*)(ag0 + ko); ra1 = *(const u32x4*)(ag1 + ko); rb0 = *(const u32x4*)(bg0 + ko); rb1 = *(const u32x4*)(bg1 + ko); }
#pragma unroll
    for (int ks = 0; ks < 2; ++ks) {
      bf16x8 af[4], bfr[2];
#pragma unroll
      for (int m = 0; m < 4; ++m) af[m] = *(const bf16x8*)(As + (wm * 64 + m * 16 + r16) * 72 + ks * 32 + g * 8);
#pragma unroll
      for (int n = 0; n < 2; ++n) bfr[n] = *(const bf16x8*)(Bs + (wn * 32 + n * 16 + r16) * 72 + ks * 32 + g * 8);
#pragma unroll
      for (int m = 0; m < 4; ++m)
#pragma unroll
        for (int n = 0; n < 2; ++n) acc[m][n] = __builtin_amdgcn_mfma_f32_16x16x32_bf16(bfr[n], af[m], acc[m][n], 0, 0, 0);
    }
  }
#pragma unroll
  for (int m = 0; m < 4; ++m)
#pragma unroll
    for (int n = 0; n < 2; ++n) epi(row0 + wm * 64 + m * 16 + r16, col0 + wn * 32 + n * 16 + 4 * g, acc[m][n]);
}

template <class Epi>
__device__ __forceinline__ void gemm_phase(const bf16_t* A, int lda, const bf16_t* Bt, int ldb, int M, int N, int K, char* lds, const Epi& epi, int tile_off, int tile_total) {
  const int nrt = M >> 7, nt = nrt * (N >> 7);
  for (int t = blockIdx.x; t < tile_total; t += gridDim.x) {
    const int u = t - tile_off;
    if (u < 0 || u >= nt) continue;
    gemm_tile(A, lda, Bt, ldb, K, (u % nrt) * 128, (u / nrt) * 128, lds, epi);
  }
}


namespace pg8 {
#define PG8_LAS __attribute__((address_space(3)))
constexpr int BM = 256, BK = 64, HALF = 128, HTB = HALF * BK * 2, STAGE_BYTES = 8 * HTB, NXCD = 8, WGM = 8;
__device__ __forceinline__ int lds_byte(int r, int c) { const int st = (r >> 4) * 2 + (c >> 5), rr = r & 15, cc = c & 31, ob = rr * 64 + cc * 2; return st * 1024 + (ob ^ (((ob >> 9) & 1) << 5)); }
__device__ __forceinline__ void stage_rc(int b, int& R, int& C) { const int st = b / 1024, sb = b % 1024, swz = sb ^ (((sb >> 9) & 1) << 5); R = (st >> 1) * 16 + swz / 64; C = (st & 1) * 32 + (swz % 64) / 2; }
__device__ __forceinline__ int perm32(int rho) { const int n = rho >> 4, i = rho & 15; return 8 * (i >> 2) + 4 * n + (i & 3); }
struct Unit { int pm, pn, kpart; };
struct Gemm { const bf16_t* A; const bf16_t* Bt; int lda, ldb, K; };
struct Order {
  int nM, nN, nwg, G, c, parts;
  __device__ void init(int M, int N, int G_, int c_, int parts_) { nM = M / BM; nN = N / BM; nwg = nM * nN; G = G_; c = c_; parts = parts_; }
  __device__ bool next(int i, Unit& u) const {
    const long L = (long)i * G + c; if (L >= (long)nwg * parts) return false;
    u.kpart = (int)(L / nwg); int wgid = (int)(L % nwg);
    { const int q = nwg / NXCD, r = nwg % NXCD, xcd = wgid % NXCD, off = wgid / NXCD; wgid = (xcd < r ? xcd * (q + 1) : r * (q + 1) + (xcd - r) * q) + off; }
    const int nig = WGM * nN, gid = wgid / nig, fm = gid * WGM, gsz = (nM - fm) < WGM ? (nM - fm) : WGM;
    u.pm = fm + ((wgid % nig) % gsz); u.pn = (wgid % nig) / gsz; return true;
  }
};
template <class Epi>
__device__ __forceinline__ void gemm_phase(PG8_LAS unsigned char* lds, const Gemm g, const Order& S, const Epi& E) {
  const int tid = otid(), wid = __builtin_amdgcn_readfirstlane(tid >> 6), lane = tid & 63, wr = wid >> 2, wc = wid & 3, fr = lane & 15, fq = lane >> 4;
  const int K = g.K, nt = K / BK;
  unsigned voffA, voffB;
  { int R, C; stage_rc(tid * 16, R, C); const int Rb = (R & ~31) + perm32(R & 31);
    voffA = (unsigned)(R * g.lda + C) * 2u; voffB = (unsigned)(Rb * g.ldb + C) * 2u; }
  const size_t rskA = (size_t)64 * g.lda * 2, rskB = (size_t)64 * g.ldb * 2;
  const size_t kstep = (size_t)(BK * 2);
  const size_t hstepA = (size_t)HALF * g.lda * 2, hstepB = (size_t)HALF * g.ldb * 2, tstepA = 2 * hstepA, tstepB = 2 * hstepB;
  const unsigned ldsw = (unsigned)wid * 1024u;
  const int aoff = lds_byte(wr * 64 + fr, fq * 8), boff = lds_byte(wc * 32 + fr, fq * 8);
#define PG8_SA(b, h) (((b) * 2 + (h)) * HTB)
#define PG8_SB(b, h) ((4 + (b) * 2 + (h)) * HTB)
#define PG8_STAGE(bufoff, gbase, voff) do { _Pragma("unroll") for (int _i = 0; _i < 2; ++_i) \
    __builtin_amdgcn_global_load_lds((const unsigned*)((const char*)(gbase) + (size_t)_i * rsk_##voff + (voff)), (PG8_LAS unsigned*)(lds + (bufoff) + ldsw + _i * 8192), 16, 0, 0); } while (0)
#define rsk_voffA rskA
#define rsk_voffB rskB
#define PG8_LDA(dst, b, h) do { _Pragma("unroll") for (int m = 0; m < 4; ++m) _Pragma("unroll") for (int k = 0; k < 2; ++k) dst[m][k] = *(const PG8_LAS bf16x8*)(lds + PG8_SA(b, h) + aoff + m * 2048 + k * 1024); } while (0)
#define PG8_LDB(dst, b, h) do { _Pragma("unroll") for (int n = 0; n < 2; ++n) _Pragma("unroll") for (int k = 0; k < 2; ++k) dst[n][k] = *(const PG8_LAS bf16x8*)(lds + PG8_SB(b, h) + boff + n * 2048 + k * 1024); } while (0)
#define PG8_MMA(ai, bj, At, Bt) do { __builtin_amdgcn_s_setprio(1); _Pragma("unroll") for (int m = 0; m < 4; ++m) _Pragma("unroll") for (int n = 0; n < 2; ++n) _Pragma("unroll") for (int k = 0; k < 2; ++k) \
    acc[ai][bj][m][n] = __builtin_amdgcn_mfma_f32_16x16x32_bf16(Bt[n][k], At[m][k], acc[ai][bj][m][n], 0, 0, 0); __builtin_amdgcn_s_setprio(0); } while (0)
#define PG8_WAIT_V(n) asm volatile("s_waitcnt vmcnt(" #n ")" ::: "memory")
#define PG8_WAIT_L(n) asm volatile("s_waitcnt lgkmcnt(" #n ")" ::: "memory")
#define PG8_BAR __builtin_amdgcn_s_barrier()
#define PG8_SCHED __builtin_amdgcn_sched_barrier(0)
  Unit cur, nxt; int ui = 0;
  if (!S.next(0, cur)) return;
  f32x4 acc[2][2][4][2];
#pragma unroll
  for (int a = 0; a < 2; ++a)
#pragma unroll
    for (int b = 0; b < 2; ++b)
#pragma unroll
      for (int m = 0; m < 4; ++m)
#pragma unroll
        for (int n = 0; n < 2; ++n) acc[a][b][m][n] = (f32x4){0.f, 0.f, 0.f, 0.f};
  bf16x8 At[4][2], B0[2][2], B1[2][2];
  const char* cA = (const char*)g.A + (size_t)cur.pm * tstepA + (size_t)cur.kpart * K * 2; const char* cB = (const char*)g.Bt + (size_t)cur.pn * tstepB + (size_t)cur.kpart * K * 2;
  PG8_STAGE(PG8_SB(0, 0), cB, voffB); PG8_STAGE(PG8_SB(0, 1), cB + hstepB, voffB); PG8_STAGE(PG8_SA(0, 0), cA, voffA); PG8_STAGE(PG8_SA(0, 1), cA + hstepA, voffA);
  if (wr == 1) PG8_BAR;
  PG8_WAIT_V(2); PG8_BAR;
  PG8_STAGE(PG8_SB(1, 0), cB + kstep, voffB); PG8_STAGE(PG8_SA(1, 0), cA + kstep, voffA); PG8_STAGE(PG8_SB(1, 1), cB + hstepB + kstep, voffB);
  PG8_WAIT_V(6); PG8_BAR;
  for (;;) {
    const bool has_next = S.next(ui + 1, nxt);
    const char* nA = has_next ? (const char*)g.A + (size_t)nxt.pm * tstepA + (size_t)nxt.kpart * K * 2 : cA; const char* nB = has_next ? (const char*)g.Bt + (size_t)nxt.pn * tstepB + (size_t)nxt.kpart * K * 2 : cB;
    for (int t = 0; t < nt; t += 2) {
      const bool last = (t == nt - 2);
      const char* a1 = cA + (size_t)(t + 1) * kstep;
      const char* a2 = last ? nA : cA + (size_t)(t + 2) * kstep; const char* b2 = last ? nB : cB + (size_t)(t + 2) * kstep;
      const char* a3 = a2 + kstep; const char* b3 = b2 + kstep;
      PG8_LDB(B0, 0, 0); PG8_LDB(B1, 0, 1); PG8_SCHED; PG8_LDA(At, 0, 0); PG8_STAGE(PG8_SA(1, 1), a1 + hstepA, voffA);
      PG8_WAIT_V(8); PG8_WAIT_L(0); PG8_BAR; PG8_MMA(0, 0, At, B0); PG8_MMA(0, 1, At, B1); PG8_BAR; PG8_SCHED;
      PG8_LDA(At, 0, 1); PG8_STAGE(PG8_SB(0, 0), b2, voffB); PG8_STAGE(PG8_SB(0, 1), b2 + hstepB, voffB); PG8_STAGE(PG8_SA(0, 0), a2, voffA);
      PG8_WAIT_V(8); PG8_WAIT_L(0); PG8_BAR; PG8_MMA(1, 0, At, B0); PG8_MMA(1, 1, At, B1); PG8_BAR; PG8_SCHED;
      PG8_LDB(B0, 1, 0); PG8_LDB(B1, 1, 1); PG8_SCHED; PG8_LDA(At, 1, 0); PG8_STAGE(PG8_SA(0, 1), a2 + hstepA, voffA);
      PG8_WAIT_V(8); PG8_WAIT_L(0); PG8_BAR; PG8_MMA(0, 0, At, B0); PG8_MMA(0, 1, At, B1); PG8_BAR; PG8_SCHED;
      PG8_LDA(At, 1, 1); PG8_STAGE(PG8_SB(1, 0), b3, voffB); PG8_STAGE(PG8_SB(1, 1), b3 + hstepB, voffB); PG8_STAGE(PG8_SA(1, 0), a3, voffA);
      PG8_WAIT_V(8); PG8_WAIT_L(0); PG8_BAR; PG8_MMA(1, 0, At, B0); PG8_MMA(1, 1, At, B1); PG8_BAR; PG8_SCHED;
    }
    if (wr == 0) PG8_BAR;
    { const int l2_ = otid() & 63; E(acc, cur, wr, wc, l2_ & 15, l2_ >> 4); }
    if (!has_next) break;
#pragma unroll
    for (int a = 0; a < 2; ++a)
#pragma unroll
      for (int b = 0; b < 2; ++b)
#pragma unroll
        for (int m = 0; m < 4; ++m)
#pragma unroll
          for (int n = 0; n < 2; ++n) acc[a][b][m][n] = (f32x4){0.f, 0.f, 0.f, 0.f};
    cur = nxt; cA = nA; cB = nB; ++ui;
    if (wr == 1) PG8_BAR;
  }
  PG8_WAIT_V(0);
  PG8_BAR;
#undef PG8_SA
#undef PG8_SB
#undef PG8_STAGE
#undef rsk_voffA
#undef rsk_voffB
#undef PG8_LDA
#undef PG8_LDB
#undef PG8_MMA
#undef PG8_WAIT_V
#undef PG8_WAIT_L
#undef PG8_BAR
#undef PG8_SCHED
}
}
template <class F> struct EpiAd { F f;
  __device__ __forceinline__ void operator()(const f32x4 (&acc)[2][2][4][2], const pg8::Unit& u, int wr, int wc, int fr, int fq) const {
#pragma unroll
    for (int ai = 0; ai < 2; ++ai)
#pragma unroll
      for (int m = 0; m < 4; ++m) { const int row = u.pm * 256 + ai * 128 + wr * 64 + m * 16 + fr;
#pragma unroll
        for (int bj = 0; bj < 2; ++bj)
        { f(row, u.pn * 256 + bj * 128 + wc * 32 + 8 * fq, acc[ai][bj][m][0], acc[ai][bj][m][1], u.kpart); asm volatile("" ::: "memory"); }
        asm volatile("" ::: "memory"); }
  } };
template <class F>
__device__ __forceinline__ void big_gemm(PG8_LAS unsigned char* lds, const bf16_t* A, int lda, const bf16_t* Bt, int ldb, int M, int N, int Kpart, int parts, int c0, const F& f) {
  pg8::Gemm g{A, Bt, lda, ldb, Kpart}; pg8::Order S; S.init(M, N, (int)gridDim.x, (int)((blockIdx.x + c0) % gridDim.x), parts);
  EpiAd<F> E{f}; pg8::gemm_phase<EpiAd<F>>(lds, g, S, E);
}

__device__ __forceinline__ u32x4 pk8(f32x4 a, f32x4 b) { u32x4 w; w.x = pk2(a[0], a[1]); w.y = pk2(a[2], a[3]); w.z = pk2(b[0], b[1]); w.w = pk2(b[2], b[3]); return w; }
struct EpiZ { bf16_t* Z; float* gates; const float* b_gates;
  __device__ __forceinline__ void operator()(int row, int col, f32x4 v0, f32x4 v1, int kp = 0) const {
    *(u32x4*)(Z + (size_t)row * N_INP + col) = pk8(v0, v1);
    if (col >= OFF_GATE && col < OFF_GATE + 16) { const int c = col - OFF_GATE; *(f32x4*)(gates + (size_t)row * 16 + c) = v0 + *(const f32x4*)(b_gates + c); *(f32x4*)(gates + (size_t)row * 16 + c + 4) = v1 + *(const f32x4*)(b_gates + c + 4); }
  } };
struct EpiQ { bf16_t* Q; const float* rope;
  __device__ __forceinline__ f32x4 rot(int row, int col, f32x4 v) const {
    const int r = col % 96;
    if (r >= 64 && row >= NCTX) {
      const int pp = r - 64, hf = pp >> 4, i0 = (pp & 15) >> 1; const int n = (row - NCTX) & 2047; const int pos = hf ? (n & 63) : (n >> 6);
      const f32x4 cs = *(const f32x4*)(rope + (pos * 8 + i0) * 2);
      v = (f32x4){v[0] * cs[0] - v[1] * cs[1], v[0] * cs[1] + v[1] * cs[0], v[2] * cs[2] - v[3] * cs[3], v[2] * cs[3] + v[3] * cs[2]};
    }
    return v;
  }
  __device__ __forceinline__ void operator()(int row, int col, f32x4 v0, f32x4 v1, int kp = 0) const { *(u32x4*)(Q + (size_t)row * 768 + col) = pk8(rot(row, col, v0), rot(row, col + 4, v1)); } };
struct EpiBf { bf16_t* O; int ldc;
  __device__ __forceinline__ void operator()(int row, int col, f32x4 v0, f32x4 v1, int kp = 0) const { *(u32x4*)(O + (size_t)row * ldc + col) = pk8(v0, v1); } };
__device__ __forceinline__ f32x4 sig4lo(u32x4 z) { return (f32x4){sigmoidf_(bflo(z.x)), sigmoidf_(bfhi(z.x)), sigmoidf_(bflo(z.y)), sigmoidf_(bfhi(z.y))}; }
__device__ __forceinline__ f32x4 sig4hi(u32x4 z) { return (f32x4){sigmoidf_(bflo(z.z)), sigmoidf_(bfhi(z.z)), sigmoidf_(bflo(z.w)), sigmoidf_(bfhi(z.w))}; }
struct EpiT1 { bf16_t* T1; const bf16_t* Z;
  __device__ __forceinline__ void operator()(int row, int col, f32x4 v0, f32x4 v1, int kp = 0) const {
    const u32x4 zz = *(const u32x4*)(Z + (size_t)row * N_INP + OFF_BR + col);
    *(u32x4*)(T1 + (size_t)row * 1024 + col) = pk8(v0 * sig4lo(zz), v1 * sig4hi(zz));
  } };
struct EpiMG { const bf16_t* T1; const bf16_t* Z; bf16_t* MG;
  __device__ __forceinline__ void operator()(int row, int col, f32x4 v0, f32x4 v1, int kp = 0) const {
    const u32x4 zz = *(const u32x4*)(Z + (size_t)row * N_INP + OFF_BR + 1024 + col);
    const u32x4 t = *(const u32x4*)(T1 + (size_t)row * 1024 + col);
    const f32x4 t0 = {bflo(t.x), bfhi(t.x), bflo(t.y), bfhi(t.y)}, t1 = {bflo(t.z), bfhi(t.z), bflo(t.w), bfhi(t.w)};
    *(u32x4*)(MG + (size_t)row * 1024 + col) = pk8(t0 + v0 * sig4lo(zz), t1 + v1 * sig4hi(zz));
  } };
struct EpiPart { bf16_t* P0; bf16_t* P1;
  __device__ __forceinline__ void operator()(int row, int col, f32x4 v0, f32x4 v1, int kp = 0) const { *(u32x4*)((kp ? P1 : P0) + (size_t)row * 1024 + col) = pk8(v0, v1); } };
struct EpiAct { bf16_t* ACT;
  __device__ __forceinline__ void operator()(int row, int hcol, f32x4 a0, f32x4 a1, f32x4 u0, f32x4 u1) const {
    f32x4 o0, o1;
#pragma unroll
    for (int i = 0; i < 4; ++i) { o0[i] = a0[i] * sigmoidf_(a0[i]) * u0[i]; o1[i] = a1[i] * sigmoidf_(a1[i]) * u1[i]; }
    *(u32x4*)(ACT + (size_t)row * FFN + hcol) = pk8(o0, o1);
  } };

__device__ __forceinline__ int map_col(int wid, int n) {
  if (wid == 0) return n < N_IN ? n : -1;
  if (wid == 1) { const int h = n / 96, r = n % 96; if (r < 64) return n; const int pp = r - 64; return h * 96 + 64 + (pp >> 4) * 16 + (pp & 1) * 8 + ((pp & 15) >> 1); }
  if (wid == 6) return ((n >> 7) & 1) * FFN + (n >> 8) * 128 + (n & 127);
  return n;
}

__device__ void phase_prologue(const Params& p, char* lds) {
  const int tid = otid();
  float* fl = (float*)lds;
  if (blockIdx.x == 0) {
    if (tid == 0) { unsigned* ctrl = (unsigned*)(p.ws + WS_CTRL); ctrl[0] = 0u; }
    if (tid < 8) {
      double th = 1.0; for (int k = 0; k < tid; ++k) th *= 0.31622776601683794;
      double x2 = th * th, s = th, c = 1.0, ts = th, tc = 1.0;
      for (int k = 1; k <= 12; ++k) { tc = -tc * x2 / (double)((2 * k - 1) * (2 * k)); c += tc; ts = -ts * x2 / (double)((2 * k) * (2 * k + 1)); s += ts; }
      double cc = 1.0, ss = 0.0; float* rope = (float*)(p.ws + WS_ROPE);
      for (int pos = 0; pos < 64; ++pos) { rope[(pos * 8 + tid) * 2] = (float)cc; rope[(pos * 8 + tid) * 2 + 1] = (float)ss; const double nc = cc * c - ss * s, ns = ss * c + cc * s; cc = nc; ss = ns; }
    }
  }
  if (blockIdx.x < 192) {
    const int q = tid & 7, ks = tid >> 3; const int col = blockIdx.x * 32 + q * 4;
    f32x4 a0 = {0, 0, 0, 0}, a1 = a0, a2 = a0;
#pragma unroll 4
    for (int i = 0; i < 16; ++i) {
      const int k = ks * 16 + i;
      const f32x4 w = __builtin_nontemporal_load((const f32x4*)(p.w_mod + (size_t)k * 6144 + col));
      float c0 = p.c_ctx[k], c1 = p.c[k], c2 = p.c[1024 + k];
      c0 = c0 * sigmoidf_(c0); c1 = c1 * sigmoidf_(c1); c2 = c2 * sigmoidf_(c2);
      a0 += w * c0; a1 += w * c1; a2 += w * c2;
    }
    float* r = fl + (ks * 8 + q) * 12;
    *(f32x4*)(r) = a0; *(f32x4*)(r + 4) = a1; *(f32x4*)(r + 8) = a2;
    __syncthreads();
    if (tid < 96) {
      const int qq = tid / 12, e = tid % 12; float s = 0.f;
      for (int k2 = 0; k2 < 64; ++k2) s += fl[(k2 * 8 + qq) * 12 + e];
      const int cc = e >> 2, i = e & 3, cl = blockIdx.x * 32 + qq * 4 + i;
      ((float*)(p.ws + WS_MOD))[cc * 6144 + cl] = s + p.b_mod[cl];
    }
    __syncthreads();
  }
  constexpr int NT0 = 16 * 92, NT1 = 6 * 12, NT2 = 4 * 16, NT3 = 8 * 16, NT4 = 16 * 16, NT5 = 16 * 16, NT6 = 16 * 88, NT7 = 44 * 16;
  constexpr int TOT = NT0 + NT1 + NT2 + NT3 + NT4 + NT5 + NT6 + NT7;
  for (int t = blockIdx.x; t < TOT; t += gridDim.x) {
    int wid, u = t; const float* W; int K, N; bf16_t* Wt;
    if (u < NT0) { wid = 0; W = p.w_in; K = 1024; N = N_IN; Wt = (bf16_t*)(p.ws + WS_WIN); }
    else if ((u -= NT0) < NT1) { wid = 1; W = p.w_uq; K = 384; N = 768; Wt = (bf16_t*)(p.ws + WS_WUQ); }
    else if ((u -= NT1) < NT2) { wid = 2; W = p.w_ukv; K = 256; N = 1024; Wt = (bf16_t*)(p.ws + WS_WUKV); }
    else if ((u -= NT2) < NT3) { wid = 3; W = p.w_o_mla; K = 512; N = 1024; Wt = (bf16_t*)(p.ws + WS_WOMLA); }
    else if ((u -= NT3) < NT4) { wid = 4; W = p.w_o_mlstm; K = 1024; N = 1024; Wt = (bf16_t*)(p.ws + WS_WOMLSTM); }
    else if ((u -= NT4) < NT5) { wid = 5; W = p.w_out; K = 1024; N = 1024; Wt = (bf16_t*)(p.ws + WS_WOUT); }
    else if ((u -= NT5) < NT6) { wid = 6; W = p.w_ffn_in; K = 1024; N = 5632; Wt = (bf16_t*)(p.ws + WS_WFIN); }
    else { u -= NT6; wid = 7; W = p.w_ffn_out; K = 2816; N = 1024; Wt = (bf16_t*)(p.ws + WS_WFOUT); }
    const int nkt = K >> 6; const int kt = u % nkt, nt = u / nkt;
    {
      typedef float f32x2v __attribute__((ext_vector_type(2)));
      const int n4 = (tid & 15) * 4; const int n = nt * 64 + n4;
      const float scale = (wid == 0 && n >= OFF_MK && n < OFF_MK + 512) ? 0.08838834764831845f : 1.0f;
#pragma unroll
      for (int i = 0; i < 2; ++i) { const int k = (tid >> 4) + 32 * i; const float* wr_ = W + (size_t)(kt * 64 + k) * N; f32x4 v;
        if (wid == 6) v = __builtin_nontemporal_load((const f32x4*)(wr_ + map_col(6, n)));
        else if (wid == 1 && (n % 96) >= 64) { const int s0 = map_col(1, n), s1 = map_col(1, n + 1); const f32x2v x1 = *(const f32x2v*)(wr_ + s0), x2 = *(const f32x2v*)(wr_ + s1); v = (f32x4){x1[0], x2[0], x1[1], x2[1]}; }
        else if (wid == 0 && n >= N_IN) v = (f32x4){0.f, 0.f, 0.f, 0.f};
        else v = __builtin_nontemporal_load((const f32x4*)(wr_ + n));
        v = v * scale;
        fl[k * 65 + n4] = v[0]; fl[k * 65 + n4 + 1] = v[1]; fl[k * 65 + n4 + 2] = v[2]; fl[k * 65 + n4 + 3] = v[3]; }
    }
    __syncthreads();
    {
      const int nl = tid >> 3, k8 = (tid & 7) * 8; u32x4 w;
      w.x = pk2(fl[(k8 + 0) * 65 + nl], fl[(k8 + 1) * 65 + nl]); w.y = pk2(fl[(k8 + 2) * 65 + nl], fl[(k8 + 3) * 65 + nl]);
      w.z = pk2(fl[(k8 + 4) * 65 + nl], fl[(k8 + 5) * 65 + nl]); w.w = pk2(fl[(k8 + 6) * 65 + nl], fl[(k8 + 7) * 65 + nl]);
      *(u32x4*)(Wt + (size_t)(nt * 64 + nl) * K + kt * 64 + k8) = w;
    }
    __syncthreads();
  }
}

__device__ __forceinline__ void unpk8(u32x4 w, f32x4& a, f32x4& b) { a = (f32x4){bflo(w.x), bfhi(w.x), bflo(w.y), bfhi(w.y)}; b = (f32x4){bflo(w.z), bfhi(w.z), bflo(w.w), bfhi(w.w)}; }
__device__ void phase_norm_mod(const Params& p, const bf16_t* PA, const bf16_t* PB, int gi, bf16_t* Xout, const float* g, int ish, int isc, bf16_t* H) {
  const int tid_ = otid(); const int wave = tid_ >> 6, lane = tid_ & 63; const float* mod = (const float*)(p.ws + WS_MOD);
  for (int tok = blockIdx.x * 8 + wave; tok < T; tok += gridDim.x * 8) {
    const float* xr = xrow(p, tok); const int cd = cond_of(tok);
    f32x4 v[4]; float ss = 0.f;
#pragma unroll
    for (int i = 0; i < 2; ++i) { const int col = i * 512 + lane * 8; v[2 * i] = __builtin_nontemporal_load((const f32x4*)(xr + col)); v[2 * i + 1] = __builtin_nontemporal_load((const f32x4*)(xr + col + 4));
      if (PA) { f32x4 a0, a1, b0, b1; unpk8(__builtin_nontemporal_load((const u32x4*)(PA + (size_t)tok * 1024 + col)), a0, a1); unpk8(__builtin_nontemporal_load((const u32x4*)(PB + (size_t)tok * 1024 + col)), b0, b1);
        const f32x4 gt0 = *(const f32x4*)(mod + (cd * 6 + gi) * 1024 + col), gt1 = *(const f32x4*)(mod + (cd * 6 + gi) * 1024 + col + 4);
        v[2 * i] = v[2 * i] + gt0 * (a0 + b0); v[2 * i + 1] = v[2 * i + 1] + gt1 * (a1 + b1);
        *(u32x4*)(Xout + (size_t)tok * 1024 + col) = pk8(v[2 * i], v[2 * i + 1]); }
#pragma unroll
      for (int h2 = 0; h2 < 2; ++h2) { const f32x4 t = v[2 * i + h2]; ss += t[0] * t[0] + t[1] * t[1] + t[2] * t[2] + t[3] * t[3]; } }
    ss = wave_sum(ss); const float rstd = rsqrtf(ss * (1.f / 1024.f) + EPS);
#pragma unroll
    for (int i = 0; i < 2; ++i) { const int col = i * 512 + lane * 8; f32x4 o[2];
#pragma unroll
      for (int h2 = 0; h2 < 2; ++h2) { const int c = col + 4 * h2; const f32x4 gg = *(const f32x4*)(g + c), sc = *(const f32x4*)(mod + (cd * 6 + isc) * 1024 + c), sh = *(const f32x4*)(mod + (cd * 6 + ish) * 1024 + c);
        o[h2] = v[2 * i + h2] * rstd * gg * (sc + 1.f) + sh; }
      *(u32x4*)(H + (size_t)tok * 1024 + col) = pk8(o[0], o[1]); }
  }
}
__device__ void phase_final_norm(const Params& p) {
  const int tid_ = otid(); const int wave = tid_ >> 6, lane = tid_ & 63; const bf16_t* X1 = (const bf16_t*)(p.ws + WS_X1); const bf16_t* PA = (const bf16_t*)(p.ws + WS_PA2); const bf16_t* PB = (const bf16_t*)(p.ws + WS_PB2);
  const float* mod = (const float*)(p.ws + WS_MOD);
  for (int tok = blockIdx.x * 8 + wave; tok < T; tok += gridDim.x * 8) {
    const int cd = cond_of(tok); f32x4 v[4]; float ss = 0.f;
#pragma unroll
    for (int i = 0; i < 2; ++i) { const int col = i * 512 + lane * 8; const size_t o = (size_t)tok * 1024 + col;
      f32x4 x0, x1, a0, a1, b0, b1; unpk8(__builtin_nontemporal_load((const u32x4*)(X1 + o)), x0, x1); unpk8(__builtin_nontemporal_load((const u32x4*)(PA + o)), a0, a1); unpk8(__builtin_nontemporal_load((const u32x4*)(PB + o)), b0, b1);
      const f32x4 gt0 = *(const f32x4*)(mod + (cd * 6 + 5) * 1024 + col), gt1 = *(const f32x4*)(mod + (cd * 6 + 5) * 1024 + col + 4);
      v[2 * i] = x0 + gt0 * (a0 + b0); v[2 * i + 1] = x1 + gt1 * (a1 + b1);
#pragma unroll
      for (int h2 = 0; h2 < 2; ++h2) { const f32x4 t = v[2 * i + h2]; ss += t[0] * t[0] + t[1] * t[1] + t[2] * t[2] + t[3] * t[3]; } }
    ss = wave_sum(ss); const float rstd = rsqrtf(ss * (1.f / 1024.f) + EPS);
#pragma unroll
    for (int i = 0; i < 2; ++i)
#pragma unroll
      for (int h2 = 0; h2 < 2; ++h2) { const int c = i * 512 + lane * 8 + 4 * h2; const f32x4 gg = *(const f32x4*)(p.g_final + c); __builtin_nontemporal_store(v[2 * i + h2] * rstd * gg, (f32x4*)(p.out + OUT_Y + (size_t)tok * 1024 + c)); }
  }
}
__device__ void phase_prep(const Params& p) {
  const int tid_ = otid(); const int wave = tid_ >> 6, lane = tid_ & 63;
  const bf16_t* Z = (const bf16_t*)(p.ws + WS_Z); bf16_t* QN = (bf16_t*)(p.ws + WS_QN); bf16_t* CKV = (bf16_t*)(p.ws + WS_CKV); bf16_t* KPE = (bf16_t*)(p.ws + WS_KPE);
  const float* rope = (const float*)(p.ws + WS_ROPE);
  for (int tok = blockIdx.x * 8 + wave; tok < TKV + 1024; tok += gridDim.x * 8) {
    if (tok >= TKV) {
      const int gidx = tok - TKV; int grp, chain, c;
      if (gidx < 512) { grp = 1; chain = gidx >> 5; c = gidx & 31; } else { grp = 0; chain = (gidx - 512) >> 2; c = gidx & 3; }
      const int b = chain >> 3, dir = (chain >> 2) & 1, h = chain & 3; const int base = grp ? NCTX + b * 2048 : b * 256, S = grp ? 2048 : 256;
      const int posl = c * 64 + lane; const int tk = base + (dir ? S - 1 - posl : posl);
      const float* gp = (const float*)(p.ws + WS_GATES) + (size_t)tk * 16; const float ig = gp[dir * 4 + h], fp = gp[8 + dir * 4 + h];
      const float lf = fminf(fp, 0.f) - log1pf(__expf(-fabsf(fp)));
      float bc = lf;
#pragma unroll
      for (int o2 = 1; o2 < 64; o2 <<= 1) { const float t2 = __shfl_up(bc, o2); if (lane >= o2) bc += t2; }
      const float a = ig - bc; float pm = a;
#pragma unroll
      for (int o2 = 1; o2 < 64; o2 <<= 1) { const float t2 = __shfl_up(pm, o2); if (lane >= o2) pm = fmaxf(pm, t2); }
      *(f32x4*)((float*)(p.ws + WS_GB) + ((size_t)gidx * 64 + lane) * 4) = (f32x4){bc, a, pm, 0.f};
      if (lane == 63) { typedef float f32x2 __attribute__((ext_vector_type(2))); *(f32x2*)((float*)(p.ws + WS_GL) + (size_t)gidx * 2) = (f32x2){bc, pm}; }
      continue;
    }
    if (tok < T) {
      const bf16_t* zr = Z + (size_t)tok * N_INP;
      {
        float v[6]; float ss = 0.f;
#pragma unroll
        for (int i = 0; i < 3; ++i) { const unsigned w = __builtin_nontemporal_load((const unsigned*)(zr + OFF_ZQ + i * 128 + lane * 2)); v[2 * i] = bflo(w); v[2 * i + 1] = bfhi(w); ss += v[2 * i] * v[2 * i] + v[2 * i + 1] * v[2 * i + 1]; }
        ss = wave_sum(ss); const float rstd = rsqrtf(ss * (1.f / 384.f) + EPS);
#pragma unroll
        for (int i = 0; i < 3; ++i) { const int col = i * 128 + lane * 2; *(unsigned*)(QN + (size_t)tok * 384 + col) = pk2(v[2 * i] * rstd * p.g_q_norm[col], v[2 * i + 1] * rstd * p.g_q_norm[col + 1]); }
      }
      {
        const u32x2 w = __builtin_nontemporal_load((const u32x2*)(zr + OFF_ZKV + lane * 4)); float v0 = bflo(w.x), v1 = bfhi(w.x), v2 = bflo(w.y), v3 = bfhi(w.y);
        float ss = wave_sum(v0 * v0 + v1 * v1 + v2 * v2 + v3 * v3); const float rstd = rsqrtf(ss * (1.f / 256.f) + EPS);
        const f32x4 gg = *(const f32x4*)(p.g_kv_norm + lane * 4); const f32x4 o = {v0 * rstd * gg[0], v1 * rstd * gg[1], v2 * rstd * gg[2], v3 * rstd * gg[3]};
        u32x2 ow; ow.x = pk2(o[0], o[1]); ow.y = pk2(o[2], o[3]); *(u32x2*)(CKV + (size_t)tok * 256 + lane * 4) = ow;
        if (tok < NCTX) *(f32x4*)(p.out + OUT_CKV + (size_t)tok * 256 + lane * 4) = o;
      }
      if (lane < 16) {
        const int hf = lane >> 3, i = lane & 7; float x1 = bf2f(zr[OFF_ZKPE + hf * 16 + i]), x2 = bf2f(zr[OFF_ZKPE + hf * 16 + 8 + i]);
        if (tok < NCTX) { p.out[OUT_KROPE + (size_t)tok * 32 + hf * 16 + i] = x1; p.out[OUT_KROPE + (size_t)tok * 32 + hf * 16 + 8 + i] = x2; }
        else { const int n = (tok - NCTX) & 2047; const int pos = hf ? (n & 63) : (n >> 6); const float cs = rope[(pos * 8 + i) * 2], sn = rope[(pos * 8 + i) * 2 + 1];
          const float y1 = x1 * cs - x2 * sn, y2 = x1 * sn + x2 * cs; x1 = y1; x2 = y2; }
        *(unsigned*)(KPE + (size_t)tok * 32 + hf * 16 + 2 * i) = pk2(x1, x2);
      }
    } else {
      const int r = tok - T;
      const f32x4 cv = __builtin_nontemporal_load((const f32x4*)(p.cache_ckv + (size_t)r * 256 + lane * 4)); u32x2 ow; ow.x = pk2(cv[0], cv[1]); ow.y = pk2(cv[2], cv[3]);
      *(u32x2*)(CKV + (size_t)tok * 256 + lane * 4) = ow;
      if (lane < 16) { const int hf = lane >> 3, i = lane & 7; const float x1 = p.cache_krope[(size_t)r * 32 + hf * 16 + i], x2 = p.cache_krope[(size_t)r * 32 + hf * 16 + 8 + i];
        *(unsigned*)(KPE + (size_t)tok * 32 + hf * 16 + 2 * i) = pk2(x1, x2); }
    }
  }
}
__device__ void phase_hm(const Params& p) {
  const int tid_ = otid(); const int wave = tid_ >> 6, lane = tid_ & 63;
  const bf16_t* Z = (const bf16_t*)(p.ws + WS_Z); const bf16_t* HF = (const bf16_t*)(p.ws + WS_HF); const bf16_t* HB = (const bf16_t*)(p.ws + WS_HB); bf16_t* HM = (bf16_t*)(p.ws + WS_HM);
  for (int tok = blockIdx.x * 8 + wave; tok < T; tok += gridDim.x * 8) {
    const int col = lane * 16; float v[16]; float ss = 0.f;
#pragma unroll
    for (int i = 0; i < 2; ++i) { const u32x4 a = __builtin_nontemporal_load((const u32x4*)(HF + (size_t)tok * 1024 + col + i * 8)), b = __builtin_nontemporal_load((const u32x4*)(HB + (size_t)tok * 1024 + col + i * 8));
#pragma unroll
      for (int j = 0; j < 4; ++j) { v[i * 8 + 2 * j] = bflo(a[j]) + bflo(b[j]); v[i * 8 + 2 * j + 1] = bfhi(a[j]) + bfhi(b[j]); } }
#pragma unroll
    for (int i = 0; i < 16; ++i) ss += v[i] * v[i];
    ss += __shfl_xor(ss, 1); ss += __shfl_xor(ss, 2); ss += __shfl_xor(ss, 4); ss += __shfl_xor(ss, 8);
    const float rstd = rsqrtf(ss * (1.f / 256.f) + EPS);
#pragma unroll
    for (int i = 0; i < 2; ++i) { const u32x4 zo = __builtin_nontemporal_load((const u32x4*)(Z + (size_t)tok * N_INP + OFF_MO + col + i * 8)); u32x4 w;
#pragma unroll
      for (int j = 0; j < 4; ++j) { const int cc = col + i * 8 + 2 * j;
        w[j] = pk2(v[i * 8 + 2 * j] * rstd * p.g_mlstm_norm[cc] * sigmoidf_(bflo(zo[j])), v[i * 8 + 2 * j + 1] * rstd * p.g_mlstm_norm[cc + 1] * sigmoidf_(bfhi(zo[j]))); }
      *(u32x4*)(HM + (size_t)tok * 1024 + col + i * 8) = w; }
  }
}

__device__ void attn_item(const Params& p, int grp, int b, int h, int qb, char* lds) {
  const int tid = otid(), wave = tid >> 6, lane = tid & 63, r16 = lane & 15, g = lane >> 4;
  bf16_t* Ks = (bf16_t*)lds;
  bf16_t* Vs = Ks + 64 * 104;
  const bf16_t* Q = (const bf16_t*)(p.ws + WS_Q); const bf16_t* KV = (const bf16_t*)(p.ws + WS_KV); const bf16_t* KPE = (const bf16_t*)(p.ws + WS_KPE); bf16_t* ATT = (bf16_t*)(p.ws + WS_ATT);
  const int row0 = (grp ? NCTX + b * 2048 : b * 256) + qb * 256; const int ntile = grp ? 36 : 4;
  bf16x8 qf[2][3];
#pragma unroll
  for (int sb = 0; sb < 2; ++sb)
#pragma unroll
    for (int ks = 0; ks < 3; ++ks) qf[sb][ks] = *(const bf16x8*)(Q + (size_t)(row0 + wave * 32 + sb * 16 + r16) * 768 + h * 96 + ks * 32 + g * 8);
  const float cscale = 0.10206207261596575f * 1.4426950408889634f;
  float m_run[2] = {-1e30f, -1e30f}, l_run[2] = {0.f, 0.f}; f32x4 o[2][4];
#pragma unroll
  for (int sb = 0; sb < 2; ++sb)
#pragma unroll
    for (int i = 0; i < 4; ++i) o[sb][i] = (f32x4){0.f, 0.f, 0.f, 0.f};
  const int kkey0 = tid / 12, kch0 = tid % 12, kc1 = tid < 256 ? tid + 512 : tid, kkey1 = kc1 / 12, kch1 = kc1 % 12, vkey = tid >> 3, vc0 = (tid & 7) * 8;
  u32x4 rk0, rk1 = {0u, 0u, 0u, 0u}, rv;
  const int kb0 = grp ? NCTX + b * 2048 : b * 256, kbc = T + b * 256;
  const bf16_t* pk0 = kch0 < 8 ? KV + (size_t)(kb0 + kkey0) * 1024 + h * 128 + kch0 * 8 : KPE + (size_t)(kb0 + kkey0) * 32 + (kch0 - 8) * 8;
  const bf16_t* pk1 = kch1 < 8 ? KV + (size_t)(kb0 + kkey1) * 1024 + h * 128 + kch1 * 8 : KPE + (size_t)(kb0 + kkey1) * 32 + (kch1 - 8) * 8;
  const bf16_t* pv = KV + (size_t)(kb0 + vkey) * 1024 + h * 128 + 64 + vc0;
  const int st0 = kch0 < 8 ? 64 * 1024 : 64 * 32, st1 = kch1 < 8 ? 64 * 1024 : 64 * 32;
#define ATT_LOAD() do { rk0 = *(const u32x4*)pk0; rk1 = *(const u32x4*)pk1; rv = *(const u32x4*)pv; } while (0)
#define ATT_ADV(ktn) do { if ((ktn) == 32) { const int d_ = kbc - kb0 - 31 * 64; pk0 += (kch0 < 8 ? (ptrdiff_t)d_ * 1024 : (ptrdiff_t)d_ * 32); pk1 += (kch1 < 8 ? (ptrdiff_t)d_ * 1024 : (ptrdiff_t)d_ * 32); pv += (ptrdiff_t)d_ * 1024; } \
    else { pk0 += st0; pk1 += st1; pv += 64 * 1024; } } while (0)
  ATT_LOAD();
  for (int kt = 0; kt < ntile; ++kt) {
    __syncthreads();
    *(u32x4*)(Ks + kkey0 * 104 + kch0 * 8) = rk0;
    if (tid < 256) *(u32x4*)(Ks + kkey1 * 104 + kch1 * 8) = rk1;
    *(u32x4*)(Vs + vkey * 72 + vc0) = rv;
    __syncthreads();
    if (kt + 1 < ntile) ATT_ADV(kt + 1);
    ATT_LOAD();
    f32x4 s[2][4];
#pragma unroll
    for (int t4 = 0; t4 < 4; ++t4) { s[0][t4] = (f32x4){0.f, 0.f, 0.f, 0.f}; s[1][t4] = (f32x4){0.f, 0.f, 0.f, 0.f};
#pragma unroll
      for (int ks = 0; ks < 3; ++ks) { const bf16x8 kf = *(const bf16x8*)(Ks + (16 * t4 + r16) * 104 + ks * 32 + g * 8);
        s[0][t4] = __builtin_amdgcn_mfma_f32_16x16x32_bf16(kf, qf[0][ks], s[0][t4], 0, 0, 0); s[1][t4] = __builtin_amdgcn_mfma_f32_16x16x32_bf16(kf, qf[1][ks], s[1][t4], 0, 0, 0); } }
    bf16x8 pf[2][2];
#pragma unroll
    for (int sb = 0; sb < 2; ++sb) {
      float mx = -1e30f;
#pragma unroll
      for (int t4 = 0; t4 < 4; ++t4)
#pragma unroll
        for (int r = 0; r < 4; ++r) mx = fmaxf(mx, s[sb][t4][r]);
      mx = fmaxf(mx, __shfl_xor(mx, 16)); mx = fmaxf(mx, __shfl_xor(mx, 32));
      const float m_new = fmaxf(m_run[sb], mx * cscale); const float alpha = __builtin_amdgcn_exp2f(m_run[sb] - m_new); m_run[sb] = m_new;
      float rs = 0.f;
#pragma unroll
      for (int t4 = 0; t4 < 4; ++t4)
#pragma unroll
        for (int r = 0; r < 4; ++r) { const float pv = __builtin_amdgcn_exp2f(s[sb][t4][r] * cscale - m_new); s[sb][t4][r] = pv; rs += pv; }
      rs += __shfl_xor(rs, 16); rs += __shfl_xor(rs, 32);
      l_run[sb] = l_run[sb] * alpha + rs;
#pragma unroll
      for (int i = 0; i < 4; ++i) o[sb][i] = o[sb][i] * alpha;
#pragma unroll
      for (int kk = 0; kk < 2; ++kk) { u32x4 pw; pw.x = pk2(s[sb][2 * kk][0], s[sb][2 * kk][1]); pw.y = pk2(s[sb][2 * kk][2], s[sb][2 * kk][3]); pw.z = pk2(s[sb][2 * kk + 1][0], s[sb][2 * kk + 1][1]); pw.w = pk2(s[sb][2 * kk + 1][2], s[sb][2 * kk + 1][3]);
        pf[sb][kk] = *(const bf16x8*)&pw; }
    }
#pragma unroll
    for (int kk = 0; kk < 2; ++kk)
#pragma unroll
      for (int vt = 0; vt < 4; ++vt) {
        const bf16_t* vp = Vs + (32 * kk + 4 * g + (r16 >> 2)) * 72 + 16 * vt + 4 * (r16 & 3); const bf16x8 vf = tr_pair(vp, vp + 16 * 72);
        o[0][vt] = __builtin_amdgcn_mfma_f32_16x16x32_bf16(vf, pf[0][kk], o[0][vt], 0, 0, 0); o[1][vt] = __builtin_amdgcn_mfma_f32_16x16x32_bf16(vf, pf[1][kk], o[1][vt], 0, 0, 0);
      }
  }
#undef ATT_LOAD
#undef ATT_ADV
#pragma unroll
  for (int sb = 0; sb < 2; ++sb) { const float inv = 1.f / l_run[sb]; const int qrow = row0 + wave * 32 + sb * 16 + r16;
#pragma unroll
    for (int vt = 0; vt < 4; ++vt) { u32x2 w; w.x = pk2(o[sb][vt][0] * inv, o[sb][vt][1] * inv); w.y = pk2(o[sb][vt][2] * inv, o[sb][vt][3] * inv); *(u32x2*)(ATT + (size_t)qrow * 512 + h * 64 + 16 * vt + 4 * g) = w; } }
}

__device__ void mlstm_item(const Params& p, int grp, int chain, int slice, int cb, int ce, char* lds) {
  const int tid = otid(), wave = tid >> 6, lane = tid & 63, r16 = lane & 15, g = lane >> 4;
  const int b = chain >> 3, dir = (chain >> 2) & 1, h = chain & 3;
  const int base = grp ? NCTX + b * 2048 : b * 256, S = grp ? 2048 : 256, nc = ce - cb;
  const int gidx00 = grp ? chain * 32 : 512 + chain * 4; const int gidx0 = gidx00 + cb;
  bf16_t* Qs = (bf16_t*)lds;
  bf16_t* Ks = Qs + 64 * 136;
  bf16_t* Kw = Ks + 64 * 136;
  bf16_t* VV = Kw + 64 * 136;
  bf16_t* Sp = VV + 64 * 136;
  bf16_t* Cb = Sp + 64 * 72;
  float* fl = (float*)(Cb + 128 * 136);
  float* s_gb = fl; float* s_den = fl + 256; float* s_qn = fl + 384; float* s_n = fl + 448; float* s_nsum = fl + 576;
  const bf16_t* Z = (const bf16_t*)(p.ws + WS_Z); const f32x4* GB = (const f32x4*)(p.ws + WS_GB); typedef float f32x2 __attribute__((ext_vector_type(2))); const f32x2* GL = (const f32x2*)(p.ws + WS_GL);
  bf16_t* Hout = (bf16_t*)(p.ws + (dir ? WS_HB : WS_HF));
  const int sidx = ((b * 2 + dir) * 4 + h);
  const int lrow = tid >> 4, lch = tid & 15;
  f32x4 accC[8]; float m_run = 0.f;
  if (grp) {
    const float* C0 = p.state_C + ((size_t)sidx * 256 + slice * 128) * 128;
#pragma unroll
    for (int i = 0; i < 8; ++i) accC[i] = *(const f32x4*)(C0 + (16 * wave + r16) * 128 + 16 * i + 4 * g);
    if (tid < 128) s_n[tid] = p.state_n[sidx * 128 + tid];
    m_run = p.state_m[sidx];
  } else {
#pragma unroll
    for (int i = 0; i < 8; ++i) accC[i] = (f32x4){0.f, 0.f, 0.f, 0.f};
    if (tid < 128) s_n[tid] = 0.f;
  }
  if (cb > 0) {
    bf16_t* KwB = (bf16_t*)lds; bf16_t* VVB = KwB + 2 * 64 * 136;
    const int nd = tid & 127, npart = tid >> 7;
    __syncthreads();
    float n_part = npart == 0 ? s_n[nd] : 0.f;
    u32x4 ska_[2], skb_[2], sva_[2], svb_[2]; float swa_[2], swb_[2]; f32x2 sgl_[2];
#define SC_TOK(c_, r_) (base + (dir ? S - 1 - ((c_) * 64 + (r_)) : (c_) * 64 + (r_)))
#define SC_LOAD(c_, P) do { const bf16_t* za_ = Z + (size_t)SC_TOK(c_, lrow) * N_INP; const bf16_t* zb_ = Z + (size_t)SC_TOK(c_, lrow + 32) * N_INP; \
    ska_[P] = *(const u32x4*)(za_ + OFF_MK + h * 128 + lch * 8); skb_[P] = *(const u32x4*)(zb_ + OFF_MK + h * 128 + lch * 8); \
    sva_[P] = *(const u32x4*)(za_ + OFF_MV + h * 256 + slice * 128 + lch * 8); svb_[P] = *(const u32x4*)(zb_ + OFF_MV + h * 256 + slice * 128 + lch * 8); \
    swa_[P] = ((const float*)(GB + (size_t)(gidx00 + (c_)) * 64 + lrow))[1]; swb_[P] = ((const float*)(GB + (size_t)(gidx00 + (c_)) * 64 + lrow + 32))[1]; sgl_[P] = GL[gidx00 + (c_)]; } while (0)
    SC_LOAD(0, 0); SC_LOAD(1, 1);
    for (int c2 = 0; c2 < cb; c2 += 2) {
#pragma unroll
    for (int par = 0; par < 2; ++par) {
      const int c = c2 + par;
      bf16_t* Kw2 = KwB + par * (64 * 136); bf16_t* VV2 = VVB + par * (64 * 136);
      const float b_last = sgl_[par][0], amax = sgl_[par][1];
      const float m_new = b_last + fmaxf(m_run, amax); const float decay = __expf(b_last + m_run - m_new); m_run = m_new;
      { const float wa = __expf(b_last + swa_[par] - m_new), wb = __expf(b_last + swb_[par] - m_new); u32x4 wa4, wb4;
#pragma unroll
        for (int jj = 0; jj < 4; ++jj) { wa4[jj] = pk2(wa * bflo(ska_[par][jj]), wa * bfhi(ska_[par][jj])); wb4[jj] = pk2(wb * bflo(skb_[par][jj]), wb * bfhi(skb_[par][jj])); }
        *(u32x4*)(Kw2 + lrow * 136 + lch * 8) = wa4; *(u32x4*)(Kw2 + (lrow + 32) * 136 + lch * 8) = wb4;
        *(u32x4*)(VV2 + lrow * 136 + lch * 8) = sva_[par]; *(u32x4*)(VV2 + (lrow + 32) * 136 + lch * 8) = svb_[par]; }
      __syncthreads();
      SC_LOAD((c + 2 < cb ? c + 2 : cb - 1), par);
      bf16x8 bv[2], ka[2][8], dm0, dm1;
      tr_frag4<0, 32 * 136 * 2, 0, 32 * 136 * 2, 4 * 136 * 2>(VV2 + (8 * g + (r16 >> 2)) * 136 + 16 * wave + 4 * (r16 & 3), bv[0], bv[1], dm0, dm1);
      const bf16_t* kp0 = Kw2 + (8 * g + (r16 >> 2)) * 136 + 4 * (r16 & 3);
      tr_frag4<0, 32, 64, 96, 4 * 136 * 2>(kp0, ka[0][0], ka[0][1], ka[0][2], ka[0][3]);
      tr_frag4<128, 160, 192, 224, 4 * 136 * 2>(kp0, ka[0][4], ka[0][5], ka[0][6], ka[0][7]);
      tr_frag4<32 * 136 * 2, 32 * 136 * 2 + 32, 32 * 136 * 2 + 64, 32 * 136 * 2 + 96, 4 * 136 * 2>(kp0, ka[1][0], ka[1][1], ka[1][2], ka[1][3]);
      tr_frag4<32 * 136 * 2 + 128, 32 * 136 * 2 + 160, 32 * 136 * 2 + 192, 32 * 136 * 2 + 224, 4 * 136 * 2>(kp0, ka[1][4], ka[1][5], ka[1][6], ka[1][7]);
#pragma unroll
      for (int i = 0; i < 8; ++i) { accC[i] = accC[i] * decay;
#pragma unroll
        for (int kk = 0; kk < 2; ++kk) accC[i] = __builtin_amdgcn_mfma_f32_16x16x32_bf16(ka[kk][i], bv[kk], accC[i], 0, 0, 0); }
      { float s = 0.f;
#pragma unroll
        for (int i = 0; i < 16; ++i) s += bf2f(Kw2[(npart * 16 + i) * 136 + nd]);
        n_part = decay * n_part + s; }
    }
    }
#undef SC_LOAD
#undef SC_TOK
    s_nsum[npart * 128 + nd] = n_part;
    __syncthreads();
    if (tid < 128) s_n[tid] = (s_nsum[tid] + s_nsum[128 + tid]) + (s_nsum[256 + tid] + s_nsum[384 + tid]);
    __syncthreads();
  }
#pragma unroll
  for (int i = 0; i < 8; ++i) { u32x2 w; w.x = pk2(accC[i][0], accC[i][1]); w.y = pk2(accC[i][2], accC[i][3]); *(u32x2*)(Cb + (16 * wave + r16) * 136 + 16 * i + 4 * g) = w; }
  u32x4 qa_[2], qb_[2], ka_[2], kb_[2], va_[2], vb_[2]; f32x4 ga_[2], gbb_[2]; f32x2 gl_[2];
#define ML_TOK(c_, r_) (base + (dir ? S - 1 - ((cb + (c_)) * 64 + (r_)) : (cb + (c_)) * 64 + (r_)))
#define ML_LOAD(c_, P) do { const bf16_t* za_ = Z + (size_t)ML_TOK(c_, lrow) * N_INP; const bf16_t* zb_ = Z + (size_t)ML_TOK(c_, lrow + 32) * N_INP; \
    qa_[P] = *(const u32x4*)(za_ + OFF_MQ + h * 128 + lch * 8); qb_[P] = *(const u32x4*)(zb_ + OFF_MQ + h * 128 + lch * 8); \
    ka_[P] = *(const u32x4*)(za_ + OFF_MK + h * 128 + lch * 8); kb_[P] = *(const u32x4*)(zb_ + OFF_MK + h * 128 + lch * 8); \
    va_[P] = *(const u32x4*)(za_ + OFF_MV + h * 256 + slice * 128 + lch * 8); vb_[P] = *(const u32x4*)(zb_ + OFF_MV + h * 256 + slice * 128 + lch * 8); \
    ga_[P] = GB[(size_t)(gidx0 + (c_)) * 64 + lrow]; gbb_[P] = GB[(size_t)(gidx0 + (c_)) * 64 + lrow + 32]; gl_[P] = GL[gidx0 + (c_)]; } while (0)
  ML_LOAD(0, 0); ML_LOAD(1, 1);
  for (int c2 = 0; c2 < nc; c2 += 2) {
#pragma unroll
  for (int par = 0; par < 2; ++par) {
    const int c = c2 + par;
    const float b_last = gl_[par][0], amax = gl_[par][1];
    const float m_old = m_run; const float m_new = b_last + fmaxf(m_old, amax); const float decay = __expf(b_last + m_old - m_new); m_run = m_new;
    {
      const float wa = __expf(b_last + ga_[par][1] - m_new), wb = __expf(b_last + gbb_[par][1] - m_new);
      if (lch == 0) { *(f32x4*)(s_gb + lrow * 4) = ga_[par]; *(f32x4*)(s_gb + (lrow + 32) * 4) = gbb_[par]; }
      *(u32x4*)(Qs + lrow * 136 + lch * 8) = qa_[par]; *(u32x4*)(Qs + (lrow + 32) * 136 + lch * 8) = qb_[par];
      *(u32x4*)(Ks + lrow * 136 + lch * 8) = ka_[par]; *(u32x4*)(Ks + (lrow + 32) * 136 + lch * 8) = kb_[par];
      u32x4 wa4, wb4;
#pragma unroll
      for (int jj = 0; jj < 4; ++jj) { wa4[jj] = pk2(wa * bflo(ka_[par][jj]), wa * bfhi(ka_[par][jj])); wb4[jj] = pk2(wb * bflo(kb_[par][jj]), wb * bfhi(kb_[par][jj])); }
      *(u32x4*)(Kw + lrow * 136 + lch * 8) = wa4; *(u32x4*)(Kw + (lrow + 32) * 136 + lch * 8) = wb4;
      *(u32x4*)(VV + lrow * 136 + lch * 8) = va_[par]; *(u32x4*)(VV + (lrow + 32) * 136 + lch * 8) = vb_[par];
    }
    __syncthreads();
    ML_LOAD((c + 2 < nc ? c + 2 : nc - 1), par);
    {
      const int j = tid >> 3, part = tid & 7; float s = 0.f;
#pragma unroll
      for (int i = 0; i < 2; ++i) { const u32x4 qq = *(const u32x4*)(Qs + j * 136 + part * 16 + i * 8); const f32x4 n0 = *(const f32x4*)(s_n + part * 16 + i * 8), n1 = *(const f32x4*)(s_n + part * 16 + i * 8 + 4);
        s += bflo(qq[0]) * n0[0] + bfhi(qq[0]) * n0[1] + bflo(qq[1]) * n0[2] + bfhi(qq[1]) * n0[3] + bflo(qq[2]) * n1[0] + bfhi(qq[2]) * n1[1] + bflo(qq[3]) * n1[2] + bfhi(qq[3]) * n1[3]; }
      s += __shfl_xor(s, 1); s += __shfl_xor(s, 2); s += __shfl_xor(s, 4);
      if (part == 0) s_qn[j] = s;
    }
    const int jt = wave & 3; const int j = 16 * jt + r16;
    const float bj = s_gb[j * 4], mmj = fmaxf(m_old, s_gb[j * 4 + 2]); const float mr = bj + mmj;
    {
      float psum = 0.f;
#pragma unroll
      for (int u = 0; u < 2; ++u) {
        const int st = (wave >> 2) + 2 * u; f32x4 acc = {0.f, 0.f, 0.f, 0.f};
#pragma unroll
        for (int ks = 0; ks < 4; ++ks) { const bf16x8 a = *(const bf16x8*)(Ks + (16 * st + r16) * 136 + ks * 32 + g * 8), bq = *(const bf16x8*)(Qs + j * 136 + ks * 32 + g * 8);
          acc = __builtin_amdgcn_mfma_f32_16x16x32_bf16(a, bq, acc, 0, 0, 0); }
        float sv[4]; float ps = 0.f;
#pragma unroll
        for (int r = 0; r < 4; ++r) { const int si = 16 * st + 4 * g + r; const float ev = __expf(fminf(bj + s_gb[si * 4 + 1] - mr, 0.f)); const float dv = (si <= j) ? ev : 0.f; sv[r] = acc[r] * dv; ps += sv[r]; }
        u32x2 w; w.x = pk2(sv[0], sv[1]); w.y = pk2(sv[2], sv[3]); *(u32x2*)(Sp + j * 72 + 16 * st + 4 * g) = w;
        ps += __shfl_xor(ps, 16); ps += __shfl_xor(ps, 32);
        psum += ps;
      }
      if (g == 0) s_den[(wave >> 2) * 64 + j] = psum;
    }
    __syncthreads();
    {
      const float wi = __expf(m_old - mmj); const float den = (s_den[j] + s_den[64 + j]) + wi * s_qn[j]; const float inv = 1.f / fmaxf(fabsf(den), __expf(-mr));
      const int tkj = ML_TOK(c, j);
      bf16x8 va[2][4];
      const bf16_t* vp0 = VV + (8 * g + (r16 >> 2)) * 136 + 64 * (wave >> 2) + 4 * (r16 & 3);
      tr_frag4<0, 32, 64, 96, 4 * 136 * 2>(vp0, va[0][0], va[0][1], va[0][2], va[0][3]);
      tr_frag4<32 * 136 * 2, 32 * 136 * 2 + 32, 32 * 136 * 2 + 64, 32 * 136 * 2 + 96, 4 * 136 * 2>(vp0, va[1][0], va[1][1], va[1][2], va[1][3]);
      bf16x8 bs[2], bq[4];
#pragma unroll
      for (int kk = 0; kk < 2; ++kk) bs[kk] = *(const bf16x8*)(Sp + j * 72 + 32 * kk + 8 * g);
#pragma unroll
      for (int kk = 0; kk < 4; ++kk) bq[kk] = *(const bf16x8*)(Qs + j * 136 + 32 * kk + 8 * g);
#pragma unroll
      for (int u = 0; u < 4; ++u) {
        const int vt2 = 4 * (wave >> 2) + u; f32x4 intra = {0.f, 0.f, 0.f, 0.f}, inter = {0.f, 0.f, 0.f, 0.f};
#pragma unroll
        for (int kk = 0; kk < 2; ++kk) intra = __builtin_amdgcn_mfma_f32_16x16x32_bf16(va[kk][u], bs[kk], intra, 0, 0, 0);
#pragma unroll
        for (int kk = 0; kk < 4; ++kk) { const bf16x8 a = *(const bf16x8*)(Cb + (16 * vt2 + r16) * 136 + 32 * kk + 8 * g); inter = __builtin_amdgcn_mfma_f32_16x16x32_bf16(a, bq[kk], inter, 0, 0, 0); }
        u32x2 w; w.x = pk2((intra[0] + wi * inter[0]) * inv, (intra[1] + wi * inter[1]) * inv); w.y = pk2((intra[2] + wi * inter[2]) * inv, (intra[3] + wi * inter[3]) * inv);
        *(u32x2*)(Hout + (size_t)tkj * 1024 + h * 256 + slice * 128 + 16 * vt2 + 4 * g) = w;
      }
    }
    {
      bf16x8 bv[2], ka[2][8], dm0, dm1;
      tr_frag4<0, 32 * 136 * 2, 0, 32 * 136 * 2, 4 * 136 * 2>(VV + (8 * g + (r16 >> 2)) * 136 + 16 * wave + 4 * (r16 & 3), bv[0], bv[1], dm0, dm1);
      const bf16_t* kp0 = Kw + (8 * g + (r16 >> 2)) * 136 + 4 * (r16 & 3);
      tr_frag4<0, 32, 64, 96, 4 * 136 * 2>(kp0, ka[0][0], ka[0][1], ka[0][2], ka[0][3]);
      tr_frag4<128, 160, 192, 224, 4 * 136 * 2>(kp0, ka[0][4], ka[0][5], ka[0][6], ka[0][7]);
      tr_frag4<32 * 136 * 2, 32 * 136 * 2 + 32, 32 * 136 * 2 + 64, 32 * 136 * 2 + 96, 4 * 136 * 2>(kp0, ka[1][0], ka[1][1], ka[1][2], ka[1][3]);
      tr_frag4<32 * 136 * 2 + 128, 32 * 136 * 2 + 160, 32 * 136 * 2 + 192, 32 * 136 * 2 + 224, 4 * 136 * 2>(kp0, ka[1][4], ka[1][5], ka[1][6], ka[1][7]);
#pragma unroll
      for (int i = 0; i < 8; ++i) {
        accC[i] = accC[i] * decay;
#pragma unroll
        for (int kk = 0; kk < 2; ++kk) accC[i] = __builtin_amdgcn_mfma_f32_16x16x32_bf16(ka[kk][i], bv[kk], accC[i], 0, 0, 0);
      }
      { const int d = tid & 127, part = tid >> 7; float s = 0.f;
#pragma unroll
        for (int i = 0; i < 16; ++i) s += bf2f(Kw[(part * 16 + i) * 136 + d]);
        s_nsum[part * 128 + d] = s; }
    }
    __syncthreads();
#pragma unroll
    for (int i = 0; i < 8; ++i) { u32x2 w; w.x = pk2(accC[i][0], accC[i][1]); w.y = pk2(accC[i][2], accC[i][3]); *(u32x2*)(Cb + (16 * wave + r16) * 136 + 16 * i + 4 * g) = w; }
    if (tid < 128) s_n[tid] = decay * s_n[tid] + ((s_nsum[tid] + s_nsum[128 + tid]) + (s_nsum[256 + tid] + s_nsum[384 + tid]));
  }
  }
#undef ML_LOAD
#undef ML_TOK
  if (!grp) {
    float* Co = p.out + OUT_C + ((size_t)sidx * 256 + slice * 128) * 128;
#pragma unroll
    for (int i = 0; i < 8; ++i) *(f32x4*)(Co + (16 * wave + r16) * 128 + 16 * i + 4 * g) = accC[i];
    if (slice == 0) { if (tid < 128) p.out[OUT_N + sidx * 128 + tid] = s_n[tid]; if (tid == 0) p.out[OUT_M + sidx] = m_run; }
  }
}

__device__ void phase_mixer(const Params& p, char* lds) {
  unsigned* ctrl = (unsigned*)(p.ws + WS_CTRL);
  int* s_item = (int*)(lds + 128 * 1024 + 64);
  constexpr int N_ML_LAT = 128, N_AT_LAT = 128, N_ML_CTX = 256, N_AT_CTX = 128, TOTAL = N_ML_LAT + N_AT_LAT + N_ML_CTX + N_AT_CTX;
  for (;;) {
    __syncthreads();
    if (otid() == 0) *s_item = (int)atomicAdd(ctrl, 1u);
    __syncthreads();
    int it = *s_item;
    if (it >= TOTAL) break;
    int kind, a0 = 0, a1 = 0, a2 = 0, a3 = 0, a4 = 0;
    if (it < N_ML_LAT) { kind = 2; a0 = 1; a1 = (it & 31) >> 1; a2 = it & 1; a3 = 8 * (3 - (it >> 5)); a4 = a3 + 8; }
    else if ((it -= N_ML_LAT) < N_AT_LAT) { kind = 1; a0 = 1; a1 = it >> 6; a2 = (it >> 3) & 7; a3 = it & 7; }
    else if ((it -= N_AT_LAT) < N_ML_CTX) { kind = 2; a0 = 0; a1 = it >> 1; a2 = it & 1; a3 = 0; a4 = 4; }
    else { it -= N_ML_CTX; kind = 1; a0 = 0; a1 = it >> 3; a2 = it & 7; a3 = 0; }
    if (kind == 1) attn_item(p, a0, a1, a2, a3, lds);
    else mlstm_item(p, a0, a1, a2, a3, a4, lds);
  }
}

#define XB_TMO      128
#define XB_XCNT(j)  (256  + 64 * (j))
#define XB_XSUB(j)  (1280 + 64 * (j))
#define XB_XGEN(j)  (2304 + 64 * (j))
#define XB_TOP      3328
#define XB_TOPGEN   3392
#define XCD_BAR_WORDS 3456
#define XB_SPIN_CAP (1u << 18)
#define LAS3 __attribute__((address_space(3)))
__device__ __forceinline__ unsigned xb_ld(unsigned* p)              { return __hip_atomic_load(p, __ATOMIC_RELAXED, __HIP_MEMORY_SCOPE_AGENT); }
__device__ __forceinline__ unsigned xb_add(unsigned* p, unsigned v) { return __hip_atomic_fetch_add(p, v, __ATOMIC_RELAXED, __HIP_MEMORY_SCOPE_AGENT); }
__device__ __forceinline__ unsigned xb_xcc_id() { return (unsigned)__builtin_amdgcn_s_getreg((3 << 11) | 20) & 0xFu; }
#define XB_SPIN(cond, bar) do { unsigned _sp = 0; while (cond) { __builtin_amdgcn_s_sleep(16); \
    if ((++_sp & 255u) == 0u) { if (xb_ld(&(bar)[XB_TMO])) break; if (_sp > XB_SPIN_CAP) { atomicAdd(&(bar)[XB_TMO], 1u); break; } } } } while (0)
struct XcdBarrier { unsigned* bar; unsigned x; volatile LAS3 unsigned* st; };
__device__ __forceinline__ XcdBarrier xcd_barrier_post(unsigned* bar, volatile LAS3 unsigned* st) {
  XcdBarrier b; b.bar = bar; b.x = xb_xcc_id(); b.st = st;
  if (threadIdx.x == 0) (void)xb_add(&bar[XB_XCNT(b.x)], 1u);
  return b;
}
__device__ __forceinline__ void xcd_barrier_complete(unsigned* bar, unsigned x, unsigned& nloc, unsigned& nx) {
  const unsigned G = gridDim.x * gridDim.y * gridDim.z;
  unsigned sum, cnt, mine, sp = 0u;
  for (;;) {
    sum = 0u; cnt = 0u; mine = 0u;
#pragma unroll
    for (unsigned j = 0; j < 16; ++j) { const unsigned c = xb_ld(&bar[XB_XCNT(j)]); sum += c; cnt += (c > 0u) ? 1u : 0u; mine = (j == x) ? c : mine; }
    if (sum == G) break;
    __builtin_amdgcn_s_sleep(1);
    if ((++sp & 255u) == 0u) { if (xb_ld(&bar[XB_TMO])) break; if (sp > XB_SPIN_CAP) { atomicAdd(&bar[XB_TMO], 1u); break; } }
  }
  nloc = mine > 0u ? mine : 1u; nx = cnt > 0u ? cnt : 1u;
}
__device__ __forceinline__ void xcd_barrier(const XcdBarrier& b) {
  asm volatile("s_waitcnt vmcnt(0)" ::: "memory");
  __syncthreads();
  if (threadIdx.x == 0) {
    unsigned* bar = b.bar;
    __builtin_amdgcn_s_waitcnt(0);
    unsigned nloc = b.st[0], nx = b.st[1];
    if (nloc == 0u) { xcd_barrier_complete(bar, b.x, nloc, nx); b.st[0] = nloc; b.st[1] = nx; }
    const unsigned old = xb_add(&bar[XB_XSUB(b.x)], 1u);
    const unsigned gen = old / nloc;
    if (old + 1u == (gen + 1u) * nloc) {
      __builtin_amdgcn_fence(__ATOMIC_RELEASE, "agent");
      asm volatile("s_waitcnt vmcnt(0)" ::: "memory");
      const unsigned og = xb_add(&bar[XB_TOP], 1u);
      const unsigned tg = og / nx;
      if (og + 1u == (tg + 1u) * nx) xb_add(&bar[XB_TOPGEN], 1u);
      else XB_SPIN(xb_ld(&bar[XB_TOPGEN]) == tg, bar);
      __builtin_amdgcn_fence(__ATOMIC_ACQUIRE, "agent");
      xb_add(&bar[XB_XGEN(b.x)], 1u);
      asm volatile("s_waitcnt vmcnt(0)" ::: "memory");
    } else {
      XB_SPIN(xb_ld(&bar[XB_XGEN(b.x)]) == gen, bar);
      __builtin_amdgcn_fence(__ATOMIC_ACQUIRE, "agent");
      asm volatile("s_waitcnt vmcnt(0)" ::: "memory");
    }
  }
  __syncthreads();
}

constexpr int LDS_BYTES = 128 * 1024 + 256;
struct EpiAll { int mode; char* ws; const float* b_gates;
  template <class F> __device__ __forceinline__ void run(const F& f, const f32x4 (&acc)[2][2][4][2], const pg8::Unit& u, int wr, int wc, int fr, int fq) const {
#pragma unroll
    for (int ai = 0; ai < 2; ++ai)
#pragma unroll
      for (int m = 0; m < 4; ++m) { const int row = u.pm * 256 + ai * 128 + wr * 64 + m * 16 + fr;
#pragma unroll
        for (int bj = 0; bj < 2; ++bj)
        { f(row, u.pn * 256 + bj * 128 + wc * 32 + 8 * fq, acc[ai][bj][m][0], acc[ai][bj][m][1], u.kpart); asm volatile("" ::: "memory"); }
        asm volatile("" ::: "memory"); }
  }
  __device__ __forceinline__ void operator()(const f32x4 (&acc)[2][2][4][2], const pg8::Unit& u, int wr, int wc, int fr, int fq) const {
    bf16_t* Z = (bf16_t*)(ws + WS_Z);
    switch (mode) {
      case 0: { EpiZ e{Z, (float*)(ws + WS_GATES), b_gates}; run(e, acc, u, wr, wc, fr, fq); } break;
      case 1: { EpiQ e{(bf16_t*)(ws + WS_Q), (const float*)(ws + WS_ROPE)}; run(e, acc, u, wr, wc, fr, fq); } break;
      case 2: { EpiBf e{(bf16_t*)(ws + WS_KV), 1024}; run(e, acc, u, wr, wc, fr, fq); } break;
      case 3: { EpiT1 e{(bf16_t*)(ws + WS_T1), Z}; run(e, acc, u, wr, wc, fr, fq); } break;
      case 4: { EpiMG e{(const bf16_t*)(ws + WS_T1), Z, (bf16_t*)(ws + WS_B)}; run(e, acc, u, wr, wc, fr, fq); } break;
      case 5: { EpiPart e{(bf16_t*)(ws + WS_PA1), (bf16_t*)(ws + WS_PB1)}; run(e, acc, u, wr, wc, fr, fq); } break;
      case 6: { EpiAct e{(bf16_t*)(ws + WS_ACT)};
#pragma unroll
        for (int ai = 0; ai < 2; ++ai)
#pragma unroll
          for (int m = 0; m < 4; ++m) { e(u.pm * 256 + ai * 128 + wr * 64 + m * 16 + fr, u.pn * 128 + wc * 32 + 8 * fq, acc[ai][0][m][0], acc[ai][0][m][1], acc[ai][1][m][0], acc[ai][1][m][1]); asm volatile("" ::: "memory"); }
      } break;
      default: { EpiPart e{(bf16_t*)(ws + WS_PA2), (bf16_t*)(ws + WS_PB2)}; run(e, acc, u, wr, wc, fr, fq); } break;
    }
  } };
struct GemmDesc { size_t A, Bt; int lda, ldb, M, N, K, parts, c0, mode; };

__global__ void __launch_bounds__(512, 2) fwd_megakernel(Params p) {
  cg::grid_group grid = cg::this_grid();
  extern __shared__ __attribute__((aligned(16))) unsigned char lds_dyn[];
  PG8_LAS unsigned char* l3 = (PG8_LAS unsigned char*)lds_dyn; char* lds = (char*)lds_dyn;
  char* ws = p.ws;
  volatile LAS3 unsigned* xst = (volatile LAS3 unsigned*)(l3 + 128 * 1024);
  if (threadIdx.x < 4) xst[threadIdx.x] = 0u;
  __syncthreads();
  XcdBarrier xbar = xcd_barrier_post((unsigned*)(ws + WS_BAR), xst);
  if (p.out == nullptr) grid.sync();
#pragma unroll 1
  for (int ph = 0; ph < 15; ++ph) {
    GemmDesc d; d.mode = -1; d.A = 0; d.Bt = 0; d.lda = d.ldb = d.M = d.N = d.K = d.parts = d.c0 = 0;
    switch (ph) {
      case 0: phase_prologue(p, lds); break;
      case 1: phase_norm_mod(p, nullptr, nullptr, 0, (bf16_t*)nullptr, p.g_norm_mix, 0, 1, (bf16_t*)(ws + WS_B)); break;
      case 2: d = GemmDesc{WS_B, WS_WIN, 1024, 1024, T, N_INP, 1024, 1, 0, 0}; break;
      case 3: phase_prep(p); break;
      case 4: d = GemmDesc{WS_QN, WS_WUQ, 384, 384, T, 768, 384, 1, 0, 1}; break;
      case 5: d = GemmDesc{WS_CKV, WS_WUKV, 256, 256, TKV, 1024, 256, 1, 160, 2}; break;
      case 6: phase_mixer(p, lds); break;
      case 7: phase_hm(p); break;
      case 8: d = GemmDesc{WS_ATT, WS_WOMLA, 512, 512, T, 1024, 512, 1, 0, 3}; break;
      case 9: d = GemmDesc{WS_HM, WS_WOMLSTM, 1024, 1024, T, 1024, 1024, 1, 0, 4}; break;
      case 10: d = GemmDesc{WS_B, WS_WOUT, 1024, 1024, T, 1024, 512, 2, 0, 5}; break;
      case 11: phase_norm_mod(p, (const bf16_t*)(ws + WS_PA1), (const bf16_t*)(ws + WS_PB1), 2, (bf16_t*)(ws + WS_X1), p.g_norm_ffn, 3, 4, (bf16_t*)(ws + WS_B)); break;
      case 12: d = GemmDesc{WS_B, WS_WFIN, 1024, 1024, T, 5632, 1024, 1, 0, 6}; break;
      case 13: d = GemmDesc{WS_ACT, WS_WFOUT, FFN, FFN, T, 1024, FFN / 2, 2, 0, 7}; break;
      default: phase_final_norm(p); break;
    }
    if (d.mode >= 0) {
      pg8::Gemm g{(const bf16_t*)(ws + d.A), (const bf16_t*)(ws + d.Bt), d.lda, d.ldb, d.K}; pg8::Order S; S.init(d.M, d.N, (int)gridDim.x, (int)((blockIdx.x + d.c0) % gridDim.x), d.parts);
      EpiAll E{d.mode, ws, p.b_gates}; pg8::gemm_phase<EpiAll>(l3, g, S, E);
    }
    if (ph != 4 && ph != 8 && ph != 14) xcd_barrier(xbar);
  }
}

extern "C" void kernel_launch(void* const* d_in, const int* in_sizes, int n_in, void* d_out, int out_size, void* d_ws, size_t ws_size, hipStream_t stream) {
  static int grid_blocks = 0;
  if (!grid_blocks) {
    int dev = 0, cus = 0, per_cu = 0;
    (void)hipGetDevice(&dev);
    (void)hipDeviceGetAttribute(&cus, hipDeviceAttributeMultiprocessorCount, dev);
    (void)hipFuncSetAttribute((const void*)fwd_megakernel, hipFuncAttributeMaxDynamicSharedMemorySize, LDS_BYTES);
    (void)hipOccupancyMaxActiveBlocksPerMultiprocessor(&per_cu, fwd_megakernel, 512, LDS_BYTES);
    if (per_cu > 1) per_cu = 1;
    if (per_cu < 1) per_cu = 1;
    grid_blocks = cus * per_cu;
  }
  if (ws_size < WS_END) fprintf(stderr, "workspace too small: %zu < %zu\n", ws_size, (size_t)WS_END);
  Params p{};
  const float** pp = (const float**)&p;
  for (int i = 0; i < 26; ++i) pp[i] = (const float*)d_in[i];
  p.out = (float*)d_out; p.ws = (char*)d_ws;
  (void)hipMemsetAsync(d_ws, 0, WS_ROPE, stream);
  void* args[] = {&p};
  hipError_t e = hipLaunchCooperativeKernel((void*)fwd_megakernel, dim3(grid_blocks), dim3(512), args, LDS_BYTES, stream);
  if (e != hipSuccess) fprintf(stderr, "cooperative launch failed: %s (grid %d)\n", hipGetErrorString(e), grid_blocks);
}
```
